# Optimizing an MI355X kernel written in HIP

```python
import math
import jax, jax.numpy as jnp
from jax import lax
import numpy as np

D_MODEL = 1024
BATCH = 8
SEQ = 4096
DEPTH = 1

W_CONV = D_MODEL
CONV_WIDTH = 3
HEAD_DIM = 64
HEADS_PER_GROUP = 8
GROUP_CONFIGS = ((128, 1), (512, 4), (2048, 16))
N_GROUPS = len(GROUP_CONFIGS)
N_ATTN_HEADS = N_GROUPS * HEADS_PER_GROUP
W_QKV = N_ATTN_HEADS * HEAD_DIM
W_ATTN_OUT = HEADS_PER_GROUP * HEAD_DIM
BLOCK_Q = 64
ROPE_THETA = 10000.0
NORM_EPS = 1e-6

SPLIT_WIDTHS = (W_CONV, W_CONV, W_CONV, W_CONV,
                W_QKV, W_QKV, W_QKV,
                W_ATTN_OUT,
                D_MODEL, D_MODEL)
IN_WIDTH = sum(SPLIT_WIDTHS)
SPLIT_POINTS = tuple(int(v) for v in np.cumsum(SPLIT_WIDTHS)[:-1])

kernel_name = "hybrid_shortconv_dilated_attn_gated_merge"


def rms_norm(x, g):
    x32 = x.astype(jnp.float32)
    y = x32 * lax.rsqrt(jnp.mean(x32 * x32, axis=-1, keepdims=True) + NORM_EPS)
    return (y * g.astype(jnp.float32)).astype(x.dtype)


def rotary(t, positions):
    half = HEAD_DIM // 2
    inv_freq = ROPE_THETA ** (-jnp.arange(0, half, dtype=jnp.float32) / half)
    ang = positions.astype(jnp.float32)[:, None] * inv_freq[None, :]
    cos = jnp.cos(ang)[None, :, None, :]
    sin = jnp.sin(ang)[None, :, None, :]
    t32 = t.astype(jnp.float32)
    t1, t2 = t32[..., :half], t32[..., half:]
    out = jnp.concatenate([t1 * cos - t2 * sin, t2 * cos + t1 * sin], axis=-1)
    return out.astype(t.dtype)


def dilated_band_attention(q, k, v, window, dilation):
    B, S, H, Dh = q.shape
    half = window // (2 * dilation)
    L = S // dilation
    bq = math.gcd(L, BLOCK_Q)
    nb = L // bq
    span = bq + 2 * half

    def to_res(t):
        return t.reshape(B, L, dilation, H, Dh).transpose(0, 2, 1, 3, 4)

    qr, kr, vr = to_res(q), to_res(k), to_res(v)
    pad = ((0, 0), (0, 0), (half, half), (0, 0), (0, 0))
    kp, vp = jnp.pad(kr, pad), jnp.pad(vr, pad)
    idx = jnp.arange(nb)[:, None] * bq + jnp.arange(span)[None, :]
    kb = kp[:, :, idx]
    vb = vp[:, :, idx]
    qb = qr.reshape(B, dilation, nb, bq, H, Dh)

    scale = 1.0 / math.sqrt(Dh)
    scores = jnp.einsum('brnqhd,brnkhd->brnhqk', qb.astype(jnp.float32),
                        kb.astype(jnp.float32)) * scale
    qi = jnp.arange(bq)[:, None]
    kj = jnp.arange(span)[None, :]
    rel = kj - qi
    band = (rel >= 0) & (rel <= 2 * half)
    kpos = idx - half
    valid = (kpos >= 0) & (kpos < L)
    mask = band[None, :, :] & valid[:, None, :]
    scores = jnp.where(mask[None, None, :, None, :, :], scores, -jnp.inf)
    lse = jax.nn.logsumexp(scores, axis=-1)
    p = jnp.exp(scores - lse[..., None])
    o = jnp.einsum('brnhqk,brnkhd->brnqhd', p.astype(v.dtype), vb)

    o = o.reshape(B, dilation, L, H, Dh).transpose(0, 2, 1, 3, 4).reshape(B, S, H, Dh)
    lse = lse.transpose(0, 1, 2, 4, 3).reshape(B, dilation, L, H)
    lse = lse.transpose(0, 2, 1, 3).reshape(B, S, H)
    return o, lse


def setup_inputs(seed: int = 0) -> dict:
    key = jax.random.key(seed)
    ks = jax.random.split(key, 11)
    f32 = jnp.float32
    x = jax.random.normal(ks[0], (BATCH, SEQ, D_MODEL), f32)
    norm_g = 1.0 + 0.02 * jax.random.normal(ks[1], (D_MODEL,), f32)
    w_in = jax.random.normal(ks[2], (D_MODEL, IN_WIDTH), f32) * D_MODEL ** -0.5
    conv_w = jax.random.normal(ks[3], (CONV_WIDTH, W_CONV), f32) * CONV_WIDTH ** -0.5
    conv_b = 0.02 * jax.random.normal(ks[4], (W_CONV,), f32)
    q_norm_g = 1.0 + 0.02 * jax.random.normal(ks[5], (HEAD_DIM,), f32)
    k_norm_g = 1.0 + 0.02 * jax.random.normal(ks[6], (HEAD_DIM,), f32)
    w_branch_conv = jax.random.normal(ks[7], (W_CONV, D_MODEL), f32) * W_CONV ** -0.5
    w_branch_attn = jax.random.normal(ks[8], (W_ATTN_OUT, D_MODEL), f32) * W_ATTN_OUT ** -0.5
    w_out = jax.random.normal(ks[9], (D_MODEL, D_MODEL), f32) * D_MODEL ** -0.5
    return {"x": x, "norm_g": norm_g, "w_in": w_in, "conv_w": conv_w, "conv_b": conv_b,
            "q_norm_g": q_norm_g, "k_norm_g": k_norm_g, "w_branch_conv": w_branch_conv,
            "w_branch_attn": w_branch_attn, "w_out": w_out}


def reference(x, norm_g, w_in, conv_w, conv_b, q_norm_g, k_norm_g,
              w_branch_conv, w_branch_attn, w_out):
    B, S, _ = x.shape
    positions = jnp.arange(S)
    for _layer in range(DEPTH):
        xn = rms_norm(x, norm_g)
        proj = jnp.einsum('bsd,de->bse', xn, w_in)
        (b_c, c_c, h_c, z_c, q, k, v, z_a, g_c, g_a) = jnp.split(proj, SPLIT_POINTS, axis=-1)

        u = c_c * h_c
        up = jnp.pad(u, ((0, 0), (1, 1), (0, 0)))
        conv = up[:, :-2] * conv_w[0] + up[:, 1:-1] * conv_w[1] + up[:, 2:] * conv_w[2] + conv_b
        y_c = b_c * conv * jax.nn.silu(z_c)

        q = q.reshape(B, S, N_ATTN_HEADS, HEAD_DIM)
        k = k.reshape(B, S, N_ATTN_HEADS, HEAD_DIM)
        v = v.reshape(B, S, N_ATTN_HEADS, HEAD_DIM)
        q = rotary(rms_norm(q, q_norm_g), positions)
        k = rotary(rms_norm(k, k_norm_g), positions)
        outs, lses = [], []
        for g, (window, dilation) in enumerate(GROUP_CONFIGS):
            hs = slice(g * HEADS_PER_GROUP, (g + 1) * HEADS_PER_GROUP)
            o_g, lse_g = dilated_band_attention(q[:, :, hs], k[:, :, hs], v[:, :, hs],
                                                window, dilation)
            outs.append(o_g)
            lses.append(lse_g)
        o_all = jnp.stack(outs, axis=0)
        w_den = jax.nn.softmax(jnp.stack(lses, axis=0), axis=0)
        o_comb = jnp.sum(w_den[..., None].astype(o_all.dtype) * o_all, axis=0)
        y_a = o_comb.reshape(B, S, W_ATTN_OUT) * jax.nn.silu(z_a)

        m = (jax.nn.sigmoid(g_c) * jnp.einsum('bsc,cd->bsd', y_c, w_branch_conv)
             + jax.nn.sigmoid(g_a) * jnp.einsum('bsc,cd->bsd', y_a, w_branch_attn))
        x = x + jnp.einsum('bsd,de->bse', m, w_out)
    return x
```

```cpp
#include <hip/hip_runtime.h>
#include <hip/hip_cooperative_groups.h>
#include <cstdio>
#include <cstdint>
namespace cg = cooperative_groups;

#define LAS __attribute__((address_space(3)))
typedef unsigned short bf16_t;
typedef short bf16x8 __attribute__((ext_vector_type(8)));
typedef short s16x4 __attribute__((ext_vector_type(4)));
typedef float f32x4 __attribute__((ext_vector_type(4)));
typedef unsigned u32x4 __attribute__((ext_vector_type(4)));
typedef unsigned u32x2 __attribute__((ext_vector_type(2)));

constexpr int SEQ = 4096, DM = 1024, NBATCH = 8, MTOT = NBATCH * SEQ;
constexpr int MP = MTOT;
constexpr int NIN = 11264;
constexpr int NP = 2560;
constexpr int OFF_ZA = 0, OFF_BZ = 512, OFF_U = 1536;
constexpr int OFF_YA = OFF_ZA, OFF_YC = OFF_BZ;
constexpr int NHEADS = 24;
constexpr float NORM_EPS = 1e-6f;
constexpr float QSCALE = 0.125f * 1.4426950408889634f;

constexpr size_t MiB = 1u << 20;
constexpr size_t WS_WIN = 0;
constexpr size_t WS_WCAT = 22 * MiB;
constexpr size_t WS_WOUT = 25 * MiB;
constexpr size_t WS_ROPE = 27 * MiB;
constexpr size_t WS_LSE = 28 * MiB;
constexpr size_t WS_BAR = 31 * MiB;
constexpr size_t WS_Q = 32 * MiB;
constexpr size_t WS_K = 128 * MiB;
constexpr size_t WS_V = 224 * MiB;
constexpr size_t WS_GC = 128 * MiB;
constexpr size_t WS_GA = 192 * MiB;
constexpr size_t WS_PROJ = 320 * MiB;
constexpr size_t WS_ZA = 480 * MiB;
constexpr size_t WS_END = 480 * MiB;

static_assert(WS_V - WS_K == WS_K - WS_Q, "q/k/v spacing");
constexpr int NWAVES = 8, NTHREADS = 512;
constexpr int LDS_BYTES = 131072 + 1024;

namespace pg8 {
constexpr int BM = 256, BK = 64, HALF = 128, HTB = HALF * BK * 2, NXCD = 8, WGM = 8;
__host__ __device__ __forceinline__ int lds_byte(int r, int c) { const int st = (r >> 4) * 2 + (c >> 5), rr = r & 15, cc = c & 31, ob = rr * 64 + cc * 2; return st * 1024 + (ob ^ (((ob >> 9) & 1) << 5)); }
__host__ __device__ __forceinline__ void stage_rc(int b, int& R, int& C) { const int st = b / 1024, sb = b % 1024, swz = sb ^ (((sb >> 9) & 1) << 5); R = (st >> 1) * 16 + swz / 64; C = (st & 1) * 32 + (swz % 64) / 2; }
__host__ __device__ __forceinline__ int perm32(int rho) { const int n = rho >> 4, i = rho & 15; return 8 * (i >> 2) + 4 * n + (i & 3); }

struct Unit { int pm, pn; };
struct Gemm { const bf16_t* A; const bf16_t* Bt; int lda, ldb, K; };

struct StaticOrder {
    int nM, nN, nwg, G, c, pn0;
    __device__ void init(int M, int N, int G_, int c_, int pn0_ = 0) { nM = M / BM; nN = N / BM; nwg = nM * nN; G = G_; c = c_; pn0 = pn0_; }
    __device__ bool next(int i, Unit& u) const {
        const long L = (long)i * G + c; if (L >= nwg) return false;
        int wgid = (int)L; { const int q = nwg / NXCD, r = nwg % NXCD, xcd = wgid % NXCD, off = wgid / NXCD; wgid = (xcd < r ? xcd * (q + 1) : r * (q + 1) + (xcd - r) * q) + off; }
        const int nig = WGM * nN, gid = wgid / nig, fm = gid * WGM, gsz = (nM - fm) < WGM ? (nM - fm) : WGM;
        u.pm = fm + ((wgid % nig) % gsz); u.pn = pn0 + (wgid % nig) / gsz; return true;
    }
};

__device__ __forceinline__ unsigned cvt_pk_bf16(float lo, float hi) { unsigned r; asm volatile("v_cvt_pk_bf16_f32 %0, %1, %2" : "=v"(r) : "v"(lo), "v"(hi)); return r; }

template <class Epi, class Sched>
__device__ __forceinline__ void gemm_phase(LAS unsigned char* lds, const Gemm g, const Sched& S, const Epi& E) {
    int tid_ = threadIdx.x; asm volatile("" : "+v"(tid_));
    const int tid = tid_, wid = __builtin_amdgcn_readfirstlane(tid >> 6), lane = tid & 63, wr = wid >> 2, wc = wid & 3, fr = lane & 15, fq = lane >> 4;
    const int K = g.K, nt = K / BK;
    unsigned voffA[2], voffB[2];
#pragma unroll
    for (int i = 0; i < 2; ++i) { int R, C; stage_rc(tid * 16 + i * 8192, R, C); const int Rb = (R & ~31) + perm32(R & 31);
        voffA[i] = (unsigned)(R * g.lda + C) * 2u; voffB[i] = (unsigned)(Rb * g.ldb + C) * 2u; }
    const size_t kstep = (size_t)(BK * 2);
    const size_t hstepA = (size_t)HALF * g.lda * 2, hstepB = (size_t)HALF * g.ldb * 2;
    const size_t tstepA = 2 * hstepA, tstepB = 2 * hstepB;
    const unsigned ldsw = (unsigned)wid * 1024u;
    const int aoff = lds_byte(wr * 64 + fr, fq * 8), boff = lds_byte(wc * 32 + fr, fq * 8);
#define PG8_SA(b, h) (((b) * 2 + (h)) * HTB)
#define PG8_SB(b, h) ((4 + (b) * 2 + (h)) * HTB)
#define PG8_STAGE(bufoff, gbase, voff) do { _Pragma("unroll") for (int _i = 0; _i < 2; ++_i) \
        __builtin_amdgcn_global_load_lds((const unsigned*)((const char*)(gbase) + (voff)[_i]), (LAS unsigned*)(lds + (bufoff) + ldsw + _i * 8192), 16, 0, 0); } while (0)
#define PG8_LDA(dst, b, h) do { _Pragma("unroll") for (int m = 0; m < 4; ++m) _Pragma("unroll") for (int k = 0; k < 2; ++k) dst[m][k] = *(const LAS bf16x8*)(lds + PG8_SA(b, h) + aoff + m * 2048 + k * 1024); } while (0)
#define PG8_LDB(dst, b, h) do { _Pragma("unroll") for (int n = 0; n < 2; ++n) _Pragma("unroll") for (int k = 0; k < 2; ++k) dst[n][k] = *(const LAS bf16x8*)(lds + PG8_SB(b, h) + boff + n * 2048 + k * 1024); } while (0)
#define PG8_MMA(ai, bj, At, Bt) do { __builtin_amdgcn_s_setprio(1); _Pragma("unroll") for (int m = 0; m < 4; ++m) _Pragma("unroll") for (int n = 0; n < 2; ++n) _Pragma("unroll") for (int k = 0; k < 2; ++k) \
        acc[ai][bj][m][n] = __builtin_amdgcn_mfma_f32_16x16x32_bf16(Bt[n][k], At[m][k], acc[ai][bj][m][n], 0, 0, 0); __builtin_amdgcn_s_setprio(0); } while (0)
#define PG8_WAIT_V(n) asm volatile("s_waitcnt vmcnt(" #n ")" ::: "memory")
#define PG8_WAIT_L(n) asm volatile("s_waitcnt lgkmcnt(" #n ")" ::: "memory")
#define PG8_BAR __builtin_amdgcn_s_barrier()
#define PG8_SCHED __builtin_amdgcn_sched_barrier(0)
    Unit cur, nxt; int ui = 0;
    if (!S.next(0, cur)) return;
    f32x4 acc[2][2][4][2];
#pragma unroll
    for (int a = 0; a < 2; ++a)
#pragma unroll
        for (int b = 0; b < 2; ++b)
#pragma unroll
            for (int m = 0; m < 4; ++m)
#pragma unroll
                for (int n = 0; n < 2; ++n) acc[a][b][m][n] = (f32x4){0.f, 0.f, 0.f, 0.f};
    bf16x8 At[4][2], B0[2][2], B1[2][2];
    const char* cA = (const char*)g.A + (size_t)cur.pm * tstepA; const char* cB = (const char*)g.Bt + (size_t)cur.pn * tstepB;
    PG8_STAGE(PG8_SB(0, 0), cB, voffB); PG8_STAGE(PG8_SB(0, 1), cB + hstepB, voffB); PG8_STAGE(PG8_SA(0, 0), cA, voffA); PG8_STAGE(PG8_SA(0, 1), cA + hstepA, voffA);
    if (wr == 1) PG8_BAR;
    PG8_WAIT_V(2); PG8_BAR;
    PG8_STAGE(PG8_SB(1, 0), cB + kstep, voffB); PG8_STAGE(PG8_SA(1, 0), cA + kstep, voffA); PG8_STAGE(PG8_SB(1, 1), cB + hstepB + kstep, voffB);
    PG8_WAIT_V(6); PG8_BAR;
    for (;;) {
        const bool has_next = S.next(ui + 1, nxt);
        const char* nA = has_next ? (const char*)g.A + (size_t)nxt.pm * tstepA : cA; const char* nB = has_next ? (const char*)g.Bt + (size_t)nxt.pn * tstepB : cB;
        for (int t = 0; t < nt; t += 2) {
            const bool last = (t == nt - 2);
            const char* a1 = cA + (size_t)(t + 1) * kstep;
            const char* a2 = last ? nA : cA + (size_t)(t + 2) * kstep; const char* b2 = last ? nB : cB + (size_t)(t + 2) * kstep;
            const char* a3 = a2 + kstep; const char* b3 = b2 + kstep;
            if constexpr (Epi::MIDK > 0) { if (t == Epi::MIDK) E.mid(acc, cur, wr, wc, fr, fq); }
            PG8_LDB(B0, 0, 0); PG8_LDB(B1, 0, 1); PG8_SCHED; PG8_LDA(At, 0, 0); PG8_STAGE(PG8_SA(1, 1), a1 + hstepA, voffA);
            PG8_WAIT_V(8); PG8_WAIT_L(0); PG8_BAR; PG8_MMA(0, 0, At, B0); PG8_MMA(0, 1, At, B1); PG8_BAR; PG8_SCHED;
            PG8_LDA(At, 0, 1); PG8_STAGE(PG8_SB(0, 0), b2, voffB); PG8_STAGE(PG8_SB(0, 1), b2 + hstepB, voffB); PG8_STAGE(PG8_SA(0, 0), a2, voffA);
            PG8_WAIT_V(8); PG8_WAIT_L(0); PG8_BAR; PG8_MMA(1, 0, At, B0); PG8_MMA(1, 1, At, B1); PG8_BAR; PG8_SCHED;
            PG8_LDB(B0, 1, 0); PG8_LDB(B1, 1, 1); PG8_SCHED; PG8_LDA(At, 1, 0); PG8_STAGE(PG8_SA(0, 1), a2 + hstepA, voffA);
            PG8_WAIT_V(8); PG8_WAIT_L(0); PG8_BAR; PG8_MMA(0, 0, At, B0); PG8_MMA(0, 1, At, B1); PG8_BAR; PG8_SCHED;
            PG8_LDA(At, 1, 1); PG8_STAGE(PG8_SB(1, 0), b3, voffB); PG8_STAGE(PG8_SB(1, 1), b3 + hstepB, voffB); PG8_STAGE(PG8_SA(1, 0), a3, voffA);
            PG8_WAIT_V(8); PG8_WAIT_L(0); PG8_BAR; PG8_MMA(1, 0, At, B0); PG8_MMA(1, 1, At, B1); PG8_BAR; PG8_SCHED;
        }
        if (wr == 0) PG8_BAR;
        E(acc, cur, wr, wc, fr, fq);
        if (!has_next) break;
#pragma unroll
        for (int a = 0; a < 2; ++a)
#pragma unroll
            for (int b = 0; b < 2; ++b)
#pragma unroll
                for (int m = 0; m < 4; ++m)
#pragma unroll
                    for (int n = 0; n < 2; ++n) acc[a][b][m][n] = (f32x4){0.f, 0.f, 0.f, 0.f};
        cur = nxt; cA = nA; cB = nB; ++ui;
        if (wr == 1) PG8_BAR;
    }
    PG8_WAIT_V(0);
    PG8_BAR;
#undef PG8_SA
#undef PG8_SB
#undef PG8_STAGE
#undef PG8_LDA
#undef PG8_LDB
#undef PG8_MMA
#undef PG8_WAIT_V
#undef PG8_WAIT_L
#undef PG8_BAR
#undef PG8_SCHED
}
}

__device__ __forceinline__ float bf_lo(unsigned w) { return __uint_as_float(w << 16); }
__device__ __forceinline__ float bf_hi(unsigned w) { return __uint_as_float(w & 0xffff0000u); }
__device__ __forceinline__ float fast_rcp(float x) { return __builtin_amdgcn_rcpf(x); }
__device__ __forceinline__ float fast_exp2(float x) { return __builtin_amdgcn_exp2f(x); }
__device__ __forceinline__ float sigmoidf_(float x) { return fast_rcp(1.f + fast_exp2(-1.4426950408889634f * x)); }
__device__ __forceinline__ float siluf_(float x) { return x * sigmoidf_(x); }
__device__ __forceinline__ u32x4 pack8(const f32x4 a, const f32x4 b) {
    u32x4 w; w.x = pg8::cvt_pk_bf16(a[0], a[1]); w.y = pg8::cvt_pk_bf16(a[2], a[3]); w.z = pg8::cvt_pk_bf16(b[0], b[1]); w.w = pg8::cvt_pk_bf16(b[2], b[3]); return w;
}
__device__ __forceinline__ void unpack8(const u32x4 w, float (&f)[8]) {
    f[0] = bf_lo(w.x); f[1] = bf_hi(w.x); f[2] = bf_lo(w.y); f[3] = bf_hi(w.y); f[4] = bf_lo(w.z); f[5] = bf_hi(w.z); f[6] = bf_lo(w.w); f[7] = bf_hi(w.w);
}
__device__ __forceinline__ float wave_sum(float v) {
#pragma unroll
    for (int o = 1; o < 64; o <<= 1) v += __shfl_xor(v, o);
    return v;
}

struct EpiProj {
    static constexpr int MIDK = 0;
    bf16_t* P; bf16_t* Qb; bf16_t* ZA; bf16_t* GCp; const float* qg; const float* kg; const float* rope;
    __device__ __forceinline__ void operator()(const f32x4 (&acc)[2][2][4][2], const pg8::Unit& u, int wr, int wc, int fr, int fq) const {
        const int pn = u.pn;
        const int row0 = u.pm * 256 + wr * 64 + fr;
        if (pn >= 16 && pn < 34) {
            const int sel = pn < 22 ? 0 : (pn < 28 ? 1 : 2);
            const int hh = (pn - 16 - 6 * sel) * 4 + wc, dsh = 2 * (hh >> 3);
            bf16_t* base = Qb + (size_t)sel * ((WS_K - WS_Q) / 2) + (size_t)hh * (SEQ * 64) + 8 * fq;
            if (sel < 2) {
                const float* gp = sel == 0 ? qg : kg;
                const float sc = sel == 0 ? QSCALE : 1.f;
                const f32x4 g00 = *(const f32x4*)(gp + 8 * fq), g01 = *(const f32x4*)(gp + 8 * fq + 4), g10 = *(const f32x4*)(gp + 32 + 8 * fq), g11 = *(const f32x4*)(gp + 36 + 8 * fq);
#pragma unroll
                for (int ai = 0; ai < 2; ++ai)
#pragma unroll
                    for (int m = 0; m < 4; ++m) {
                        float ss = 0.f;
#pragma unroll
                        for (int bj = 0; bj < 2; ++bj)
#pragma unroll
                            for (int n = 0; n < 2; ++n) { const f32x4 x = acc[ai][bj][m][n]; ss += (x[0] * x[0] + x[1] * x[1]) + (x[2] * x[2] + x[3] * x[3]); }
                        ss += __shfl_xor(ss, 16); ss += __shfl_xor(ss, 32);
                        const float rinv = rsqrtf(ss * (1.f / 64.f) + NORM_EPS) * sc;
                        const int row = row0 + ai * 128 + m * 16, pos = row & (SEQ - 1), bb = row >> 12;
                        const int p = ((pos & ((1 << dsh) - 1)) << (12 - dsh)) + (pos >> dsh);
                        const float* rp = rope + pos * 64 + 8 * fq;
                        f32x4 o1[2], o2[2];
#pragma unroll
                        for (int n = 0; n < 2; ++n) {
                            const f32x4 c = *(const f32x4*)(rp + 4 * n), sn = *(const f32x4*)(rp + 32 + 4 * n);
                            const f32x4 t1 = acc[ai][0][m][n] * rinv * (n == 0 ? g00 : g01), t2 = acc[ai][1][m][n] * rinv * (n == 0 ? g10 : g11);
                            o1[n] = t1 * c - t2 * sn; o2[n] = t2 * c + t1 * sn;
                        }
                        bf16_t* dst = base + ((size_t)bb * (NHEADS * SEQ) + p) * 64;
                        __builtin_nontemporal_store(pack8(o1[0], o1[1]), (u32x4*)dst);
                        __builtin_nontemporal_store(pack8(o2[0], o2[1]), (u32x4*)(dst + 32));
                    }
            } else {
#pragma unroll
                for (int ai = 0; ai < 2; ++ai)
#pragma unroll
                    for (int m = 0; m < 4; ++m) {
                        const int row = row0 + ai * 128 + m * 16, pos = row & (SEQ - 1), bb = row >> 12;
                        const int p = ((pos & ((1 << dsh) - 1)) << (12 - dsh)) + (pos >> dsh);
                        bf16_t* dst = base + ((size_t)bb * (NHEADS * SEQ) + p) * 64;
                        __builtin_nontemporal_store(pack8(acc[ai][0][m][0], acc[ai][0][m][1]), (u32x4*)dst);
                        __builtin_nontemporal_store(pack8(acc[ai][1][m][0], acc[ai][1][m][1]), (u32x4*)(dst + 32));
                    }
            }
        } else {
            if (pn < 16) {
                const bool isu = pn < 8;
                const int cb = (isu ? OFF_U : OFF_BZ) + 128 * (pn & 7) + 32 * wc + 8 * fq;
#pragma unroll
                for (int ai = 0; ai < 2; ++ai)
#pragma unroll
                    for (int m = 0; m < 4; ++m) {
                        f32x4 v0 = acc[ai][0][m][0], v1 = acc[ai][0][m][1];
                        const f32x4 y0 = acc[ai][1][m][0], y1 = acc[ai][1][m][1];
                        if (isu) { v0 *= y0; v1 *= y1; }
                        else {
#pragma unroll
                            for (int j = 0; j < 4; ++j) { v0[j] *= siluf_(y0[j]); v1[j] *= siluf_(y1[j]); }
                        }
                        __builtin_nontemporal_store(pack8(v0, v1), (u32x4*)(P + (size_t)(row0 + ai * 128 + m * 16) * NP + cb));
                    }
            } else {
                if (pn >= 36) {
                    const int gcol = 128 * (pn - 36) + 32 * wc + 8 * fq;
#pragma unroll
                    for (int ai = 0; ai < 2; ++ai)
#pragma unroll
                        for (int m = 0; m < 4; ++m) {
                            const size_t go = (size_t)(row0 + ai * 128 + m * 16) * 1024 + gcol;
                            f32x4 sc[2], rho[2];
#pragma unroll
                            for (int n = 0; n < 2; ++n)
#pragma unroll
                                for (int j = 0; j < 4; ++j) {
                                    const float ec = fminf(fast_exp2(-1.4426950408889634f * acc[ai][0][m][n][j]), 1e30f), ea = fast_exp2(-1.4426950408889634f * acc[ai][1][m][n][j]);
                                    sc[n][j] = fast_rcp(1.f + ec); rho[n][j] = (1.f + ec) * fast_rcp(1.f + ea);
                                }
                            *(u32x4*)(GCp + go) = pack8(sc[0], sc[1]);
                            *(u32x4*)(GCp + (WS_GA - WS_GC) / 2 + go) = pack8(rho[0], rho[1]);
                        }
                    return;
                }
                bf16_t* base = P + OFF_ZA + (pn - 34) * 256 + wc * 64 + 8 * fq;
#pragma unroll
                for (int ai = 0; ai < 2; ++ai)
#pragma unroll
                    for (int m = 0; m < 4; ++m) {
                        bf16_t* dst = base + (size_t)(row0 + ai * 128 + m * 16) * NP;
                        __builtin_nontemporal_store(pack8(acc[ai][0][m][0], acc[ai][0][m][1]), (u32x4*)dst);
                        __builtin_nontemporal_store(pack8(acc[ai][1][m][0], acc[ai][1][m][1]), (u32x4*)(dst + 32));
                    }
            }
        }
    }
};

struct EpiGate {
    static constexpr int MIDK = 0;
    bf16_t* Gx;
    __device__ __forceinline__ void operator()(const f32x4 (&acc)[2][2][4][2], const pg8::Unit& u, int wr, int wc, int fr, int fq) const {
        const int row0 = u.pm * 256 + wr * 64 + fr, col0 = u.pn * 256 + wc * 32 + 8 * fq;
#pragma unroll
        for (int ai = 0; ai < 2; ++ai)
#pragma unroll
            for (int m = 0; m < 4; ++m) {
                bf16_t* dst = Gx + (size_t)(row0 + ai * 128 + m * 16) * 1024 + col0;
#pragma unroll
                for (int bj = 0; bj < 2; ++bj) {
                    f32x4 v0 = acc[ai][bj][m][0], v1 = acc[ai][bj][m][1];
#pragma unroll
                    for (int j = 0; j < 4; ++j) { v0[j] = sigmoidf_(v0[j]); v1[j] = sigmoidf_(v1[j]); }
                    *(u32x4*)(dst + bj * 128) = pack8(v0, v1);
                }
            }
    }
};

struct EpiMerge {
    static constexpr int MIDK = 8;
    const bf16_t* GC; const bf16_t* GA; bf16_t* Mb;
    __device__ __forceinline__ void mid(f32x4 (&acc)[2][2][4][2], const pg8::Unit& u, int wr, int wc, int fr_, int fq_) const {
        int fr = fr_, fq = fq_; asm volatile("" : "+v"(fr), "+v"(fq));
        const int row0 = u.pm * 256 + wr * 64 + fr, col0 = u.pn * 256 + wc * 32 + 8 * fq;
#pragma unroll
        for (int ai = 0; ai < 2; ++ai)
#pragma unroll
            for (int m = 0; m < 4; ++m) {
                const size_t go = (size_t)(row0 + ai * 128 + m * 16) * 1024 + col0;
#pragma unroll
                for (int bj = 0; bj < 2; ++bj) {
                    float rh[8]; unpack8(__builtin_nontemporal_load((const u32x4*)(GA + go + bj * 128)), rh);
#pragma unroll
                    for (int j = 0; j < 4; ++j) { acc[ai][bj][m][0][j] *= rh[j]; acc[ai][bj][m][1][j] *= rh[4 + j]; }
                }
                __builtin_amdgcn_sched_barrier(0);
            }
    }
    __device__ __forceinline__ void operator()(const f32x4 (&acc)[2][2][4][2], const pg8::Unit& u, int wr, int wc, int fr, int fq) const {
        const int row0 = u.pm * 256 + wr * 64 + fr, col0 = u.pn * 256 + wc * 32 + 8 * fq;
#pragma unroll
        for (int ai = 0; ai < 2; ++ai)
#pragma unroll
            for (int m = 0; m < 4; ++m) {
                const int row = row0 + ai * 128 + m * 16;
#pragma unroll
                for (int bj = 0; bj < 2; ++bj) {
                    const int col = col0 + bj * 128;
                    float gc[8]; unpack8(*(const u32x4*)(GC + (size_t)row * 1024 + col), gc);
                    f32x4 v0 = acc[ai][bj][m][0], v1 = acc[ai][bj][m][1];
#pragma unroll
                    for (int j = 0; j < 4; ++j) { v0[j] *= gc[j]; v1[j] *= gc[4 + j]; }
                    *(u32x4*)(Mb + (size_t)row * NP + col) = pack8(v0, v1);
                }
                __builtin_amdgcn_sched_barrier(0);
            }
    }
};

struct EpiOut {
    static constexpr int MIDK = 0;
    const float* X; float* O;
    __device__ __forceinline__ void operator()(const f32x4 (&acc)[2][2][4][2], const pg8::Unit& u, int wr, int wc, int fr, int fq) const {
        const int row0 = u.pm * 256 + wr * 64 + fr, col0 = u.pn * 256 + wc * 32 + 8 * fq;
#pragma unroll
        for (int ai = 0; ai < 2; ++ai)
#pragma unroll
            for (int m = 0; m < 4; ++m) {
                const int row = row0 + ai * 128 + m * 16;
#pragma unroll
                for (int bj = 0; bj < 2; ++bj) {
                    const size_t o = (size_t)row * DM + col0 + bj * 128;
                    const f32x4 x0 = __builtin_nontemporal_load((const f32x4*)(X + o)), x1 = __builtin_nontemporal_load((const f32x4*)(X + o + 4));
                    __builtin_nontemporal_store(x0 + acc[ai][bj][m][0], (f32x4*)(O + o)); __builtin_nontemporal_store(x1 + acc[ai][bj][m][1], (f32x4*)(O + o + 4));
                }
                __builtin_amdgcn_sched_barrier(0);
            }
    }
};

__device__ const double INVF[32] = {1.0, 0.7498942613601685, 0.5623413324356079, 0.4216965138912201, 0.3162277638912201, 0.23713737726211548, 0.17782793939113617, 0.133352130651474,
    0.10000000149011612, 0.07498941570520401, 0.05623413249850273, 0.04216965287923813, 0.03162277489900589, 0.023713737726211548, 0.017782794311642647, 0.01333521492779255,
    0.009999999776482582, 0.007498941849917173, 0.005623413249850273, 0.0042169648222625256, 0.003162277629598975, 0.00237137358635664, 0.0017782794311642647, 0.0013335214462131262,
    0.0010000000474974513, 0.0007498942431993783, 0.000562341301701963, 0.0004216965171508491, 0.0003162277571391314, 0.00023713737027719617, 0.00017782794020604342, 0.0001333521504420787};

__device__ __forceinline__ void transpose_item(const float* W, int ldw, int N, bf16_t* WT, int k0, int kd0, int n_src, int n_dst, LAS float* scr, int lane) {
    f32x4 wv[8];
#pragma unroll
    for (int i = 0; i < 8; ++i) wv[i] = __builtin_nontemporal_load((const f32x4*)(W + (size_t)(k0 + 8 * i + (lane >> 3)) * N + n_src + 4 * (lane & 7)));
#pragma unroll
    for (int i = 0; i < 8; ++i) { LAS float* d = scr + (8 * i + (lane >> 3)) * 33 + 4 * (lane & 7); d[0] = wv[i][0]; d[1] = wv[i][1]; d[2] = wv[i][2]; d[3] = wv[i][3]; }
    asm volatile("s_waitcnt lgkmcnt(0)" ::: "memory");
    const int c = lane & 7;
#pragma unroll
    for (int j = 0; j < 4; ++j) { const int n = (lane >> 3) + 8 * j; const LAS float* s = scr + (8 * c) * 33 + n;
        u32x4 o; o.x = pg8::cvt_pk_bf16(s[0 * 33], s[1 * 33]); o.y = pg8::cvt_pk_bf16(s[2 * 33], s[3 * 33]); o.z = pg8::cvt_pk_bf16(s[4 * 33], s[5 * 33]); o.w = pg8::cvt_pk_bf16(s[6 * 33], s[7 * 33]);
        *(u32x4*)(WT + (size_t)(n_dst + n) * ldw + kd0 + 8 * c) = o; }
    asm volatile("s_waitcnt lgkmcnt(0)" ::: "memory");
}

struct Ptrs {
    const float *x, *norm_g, *w_in, *conv_w, *conv_b, *qg, *kg, *wbc, *wba, *wout;
    float* out;
    bf16_t *WinT, *WcatT, *WoutT, *XN, *Mb, *PROJ, *Qb, *Kb, *Vb, *ZA;
    float *rope, *lse;
};

__device__ __forceinline__ void prologue(const Ptrs& F, LAS unsigned char* lds, int vcu, int G) {
    const int tid = threadIdx.x, lane = tid & 63, wave = tid >> 6;
    LAS float* scr = (LAS float*)(lds + wave * 16384);
    const int gw = vcu * NWAVES + wave, NGW = G * NWAVES;
    constexpr int NB_E = 36 * 8, I_E = 16 * NB_E;
    for (int it = gw; it < I_E; it += NGW) {
        const int nb = it % NB_E, kb = it / NB_E; const int nd = nb * 32;
        const int tile = nd >> 8, gidx = (nd & 255) >> 5, bj = gidx >> 2, wc = gidx & 3;
        const int ns = tile < 8 ? (bj ? 2048 : 1024) + 128 * tile + 32 * wc
                     : tile < 16 ? (bj ? 3072 : 0) + 128 * (tile - 8) + 32 * wc
                     : tile * 256 + wc * 64 + bj * 32;
        transpose_item(F.w_in, DM, NIN, F.WinT, kb * 64, kb * 64, ns, nd, scr, lane);
    }
    for (int m = gw; m < MTOT; m += 2 * NGW) {
        const int m2 = m + NGW;
        const bool has2 = m2 < MTOT;
        const f32x4* xr = (const f32x4*)(F.x + (size_t)m * DM) + lane;
        const f32x4* xr2 = (const f32x4*)(F.x + (size_t)(has2 ? m2 : m) * DM) + lane;
        const f32x4* gr = (const f32x4*)F.norm_g + lane;
        f32x4 v[4], w[4]; float s = 0.f, s2 = 0.f;
#pragma unroll
        for (int j = 0; j < 4; ++j) { v[j] = __builtin_nontemporal_load(xr + 64 * j); w[j] = __builtin_nontemporal_load(xr2 + 64 * j); }
#pragma unroll
        for (int j = 0; j < 4; ++j) { s += (v[j][0] * v[j][0] + v[j][1] * v[j][1]) + (v[j][2] * v[j][2] + v[j][3] * v[j][3]); s2 += (w[j][0] * w[j][0] + w[j][1] * w[j][1]) + (w[j][2] * w[j][2] + w[j][3] * w[j][3]); }
        const float rinv = rsqrtf(wave_sum(s) * (1.f / DM) + NORM_EPS), rinv2 = rsqrtf(wave_sum(s2) * (1.f / DM) + NORM_EPS);
        u32x2* o8 = (u32x2*)(F.XN + (size_t)m * DM) + lane;
        u32x2* o82 = (u32x2*)(F.XN + (size_t)m2 * DM) + lane;
#pragma unroll
        for (int j = 0; j < 4; ++j) { const f32x4 gg = gr[64 * j]; const f32x4 y = v[j] * rinv * gg, y2 = w[j] * rinv2 * gg;
            u32x2 p; p.x = pg8::cvt_pk_bf16(y[0], y[1]); p.y = pg8::cvt_pk_bf16(y[2], y[3]); o8[64 * j] = p;
            if (has2) { u32x2 q; q.x = pg8::cvt_pk_bf16(y2[0], y2[1]); q.y = pg8::cvt_pk_bf16(y2[2], y2[3]); o82[64 * j] = q; } }
    }
    for (int e = vcu * NTHREADS + tid; e < SEQ * 32; e += G * NTHREADS) {
        const int pos = e >> 5, i = e & 31;
        const double a = (double)(float)((float)pos * (float)INVF[i]);
        const double k = __builtin_rint(a * 0.15915494309189535);
        const double r = a - k * 6.283185307179586476925;
        const double r2 = r * r;
        double sn = 0.0, cs = 0.0;
#pragma unroll
        for (int n = 13; n >= 0; --n) {
            sn = 1.0 - sn * r2 * (1.0 / (double)((2 * n + 2) * (2 * n + 3)));
            cs = 1.0 - cs * r2 * (1.0 / (double)((2 * n + 1) * (2 * n + 2)));
        }
        F.rope[pos * 64 + i] = (float)cs; F.rope[pos * 64 + 32 + i] = (float)(sn * r);
    }
}

__device__ __forceinline__ void late_transposes(const Ptrs& F, LAS unsigned char* lds, int hw, int NHW) {
    const int tid = threadIdx.x, lane = tid & 63, wave = tid >> 6;
    LAS float* scr = (LAS float*)(lds + wave * 16384);
    constexpr int I_G = 16 * 64, I_BC = 16 * 32, I_BA = 8 * 32, I_OUT = 16 * 32, NL = I_G + I_BC + I_BA + I_OUT;
    for (int it = hw; it < NL; it += NHW) {
        int r = it;
        if (r < I_G) { const int nb = 36 * 8 + r % 64, kb = r / 64, nd = nb * 32; const int tile = nd >> 8, gidx = (nd & 255) >> 5, bj = gidx >> 2, wc = gidx & 3;
            transpose_item(F.w_in, DM, NIN, F.WinT, kb * 64, kb * 64, (bj ? 10240 : 9216) + 128 * (tile - 36) + 32 * wc, nd, scr, lane); continue; }
        r -= I_G;
        if (r < I_BC) { transpose_item(F.wbc, 1536, DM, F.WcatT, (r / 32) * 64, 512 + (r / 32) * 64, (r % 32) * 32, (r % 32) * 32, scr, lane); continue; }
        r -= I_BC;
        if (r < I_BA) { transpose_item(F.wba, 1536, DM, F.WcatT, (r / 32) * 64, (r / 32) * 64, (r % 32) * 32, (r % 32) * 32, scr, lane); continue; }
        r -= I_BA;
        transpose_item(F.wout, 1024, DM, F.WoutT, (r / 32) * 64, (r / 32) * 64, (r % 32) * 32, (r % 32) * 32, scr, lane);
    }
    __syncthreads();
}

__device__ __forceinline__ void attn_phase(LAS unsigned char* lds, const bf16_t* Qb, const bf16_t* Kb, const bf16_t* Vb, bf16_t* Ob, float* lse, int vcu, int G) {
    int tid_ = threadIdx.x; asm volatile("" : "+v"(tid_));
    const int tid = tid_, wid = __builtin_amdgcn_readfirstlane(tid >> 6), lane = tid & 63, fr = lane & 15, fq = lane >> 4;
    const int usel = wid >> 2, w4 = wid & 3;
    constexpr int NPAIR = (MP / SEQ) * NHEADS * 32;
    const int t0 = w4;
    const int dma_off = (lane >> 3) * 64 + (((lane & 7) ^ (((lane >> 4) & 3) << 1)) * 8);
    const int fk = ((fr >> 1) & 3) << 1;
    const int krow = 64 * usel + 16 * t0 + fr;
    const int koff0 = krow * 128 + ((fq ^ fk) * 16), koff1 = krow * 128 + (((fq + 4) ^ fk) * 16);
    const int fvh = (2 * fq + (fr >> 3)) & 3;
    const int vbase = 32768 + (64 * usel + 16 * t0 + 4 * fq + (fr >> 2)) * 128 + ((fr >> 1) & 1) * 16 + (fr & 1) * 8;
    const int qi = 16 * w4 + fr;
#define ATT_DECODE(IT, b_, hh_, dsh_, r_, n0_, L_) const int idx0_##IT = ((IT) & 31) * 2, bh_##IT = (IT) >> 5, hh_ = bh_##IT % NHEADS, b_ = bh_##IT / NHEADS, dsh_ = 2 * (hh_ >> 3), \
        r_ = idx0_##IT >> (6 - dsh_), n0_ = idx0_##IT & ((1 << (6 - dsh_)) - 1), L_ = SEQ >> dsh_
#define ATT_ISSUE(rowbase, buf) do { const bf16_t* kg_ = Kb + (long)(rowbase) * 64 + dma_off; const bf16_t* vg_ = Vb + (long)(rowbase) * 64 + dma_off; \
        _Pragma("unroll") for (int jj_ = 0; jj_ < 4; ++jj_) { const int j_ = wid + 8 * jj_; \
            __builtin_amdgcn_global_load_lds((const unsigned*)(kg_ + j_ * 512), (LAS unsigned*)(lds + (buf) * 65536 + j_ * 1024), 16, 0, 0); \
            __builtin_amdgcn_global_load_lds((const unsigned*)(vg_ + j_ * 512), (LAS unsigned*)(lds + (buf) * 65536 + 32768 + j_ * 1024), 16, 0, 0); } } while (0)
    f32x4 band[9];
#pragma unroll
    for (int t = 0; t < 9; ++t)
#pragma unroll
        for (int i = 0; i < 4; ++i) { const int rel = 16 * (t0 + t) + 4 * fq + i - qi; band[t][i] = (rel >= 0 && rel <= 128) ? 0.f : -INFINITY; }
    int it = vcu, buf = 0;
    bf16x8 Qn0 = (bf16x8){0, 0, 0, 0, 0, 0, 0, 0}, Qn1 = Qn0;
    if (it < NPAIR) {
        ATT_DECODE(it, b, hh, dsh, r, n0, L);
        const long rb = (long)(b * NHEADS + hh) * SEQ + r * L + 64 * n0;
        ATT_ISSUE(rb - 64, 0);
        const bf16_t* qrow = Qb + (rb + 64 * usel + qi) * 64;
        Qn0 = *(const bf16x8*)(qrow + 8 * fq); Qn1 = *(const bf16x8*)(qrow + 32 + 8 * fq);
    }
    for (; it < NPAIR; it += G) {
        ATT_DECODE(it, b, hh, dsh, r, n0, L);
        const long rb = (long)(b * NHEADS + hh) * SEQ + r * L + 64 * n0;
        const int n = n0 + usel;
        const bf16x8 Qf0 = Qn0, Qf1 = Qn1;
        asm volatile("s_waitcnt vmcnt(0)" ::: "memory");
        __syncthreads();
        const int itn = it + G;
        if (itn < NPAIR) {
            ATT_DECODE(itn, b2, hh2, dsh2, r2, n02, L2);
            const long rb2 = (long)(b2 * NHEADS + hh2) * SEQ + r2 * L2 + 64 * n02;
            ATT_ISSUE(rb2 - 64, buf ^ 1);
            const bf16_t* qrow2 = Qb + (rb2 + 64 * usel + qi) * 64;
            Qn0 = *(const bf16x8*)(qrow2 + 8 * fq); Qn1 = *(const bf16x8*)(qrow2 + 32 + 8 * fq);
        }
        const LAS unsigned char* kb = lds + buf * 65536;
        f32x4 S[9];
#pragma unroll
        for (int t = 0; t < 9; ++t) {
            const bf16x8 k0 = *(const LAS bf16x8*)(kb + koff0 + t * 2048), k1 = *(const LAS bf16x8*)(kb + koff1 + t * 2048);
            f32x4 sv = (f32x4){0.f, 0.f, 0.f, 0.f};
            sv = __builtin_amdgcn_mfma_f32_16x16x32_bf16(k0, Qf0, sv, 0, 0, 0);
            sv = __builtin_amdgcn_mfma_f32_16x16x32_bf16(k1, Qf1, sv, 0, 0, 0);
            S[t] = sv;
        }
        if (n == 0 || 64 * n + 128 > L) {
#pragma unroll
            for (int t = 0; t < 9; ++t)
#pragma unroll
                for (int i = 0; i < 4; ++i) { const int l = 64 * n - 64 + 16 * (t0 + t) + 4 * fq + i; if ((unsigned)l >= (unsigned)L) S[t][i] = -INFINITY; }
        }
        float mx = -INFINITY;
#pragma unroll
        for (int t = 0; t < 9; ++t) { S[t] += band[t]; mx = fmaxf(fmaxf(mx, fmaxf(S[t][0], S[t][1])), fmaxf(S[t][2], S[t][3])); }
        mx = fmaxf(mx, __shfl_xor(mx, 16)); mx = fmaxf(mx, __shfl_xor(mx, 32));
        float sum = 0.f;
#pragma unroll
        for (int t = 0; t < 9; ++t) {
            typedef float f32x2 __attribute__((ext_vector_type(2)));
            const f32x2 mm = (f32x2){mx, mx};
            f32x2 lo = (f32x2){S[t][0], S[t][1]}, hi = (f32x2){S[t][2], S[t][3]};
            asm("v_pk_add_f32 %0, %1, %2 neg_lo:[0,1] neg_hi:[0,1]" : "=v"(lo) : "v"(lo), "v"(mm));
            asm("v_pk_add_f32 %0, %1, %2 neg_lo:[0,1] neg_hi:[0,1]" : "=v"(hi) : "v"(hi), "v"(mm));
            const float p0 = fast_exp2(lo[0]), p1 = fast_exp2(lo[1]), p2 = fast_exp2(hi[0]), p3 = fast_exp2(hi[1]);
            S[t] = (f32x4){p0, p1, p2, p3}; sum += (p0 + p1) + (p2 + p3);
        }
        sum += __shfl_xor(sum, 16); sum += __shfl_xor(sum, 32);
        bf16x8 Pf[4];
#pragma unroll
        for (int pp = 0; pp < 4; ++pp) {
            u32x4 w; w.x = pg8::cvt_pk_bf16(S[2 * pp][0], S[2 * pp][1]); w.y = pg8::cvt_pk_bf16(S[2 * pp][2], S[2 * pp][3]);
            w.z = pg8::cvt_pk_bf16(S[2 * pp + 1][0], S[2 * pp + 1][1]); w.w = pg8::cvt_pk_bf16(S[2 * pp + 1][2], S[2 * pp + 1][3]);
            Pf[pp] = __builtin_bit_cast(bf16x8, w);
        }
        f32x4 O[4];
#pragma unroll
        for (int dt = 0; dt < 4; ++dt) O[dt] = (f32x4){0.f, 0.f, 0.f, 0.f};
        const LAS unsigned char* vb = kb + vbase;
        u32x2 w8; w8.x = pg8::cvt_pk_bf16(S[8][0], S[8][1]); w8.y = pg8::cvt_pk_bf16(S[8][2], S[8][3]);
        const s16x4 P8 = __builtin_bit_cast(s16x4, w8);
#pragma unroll
        for (int pp = 0; pp < 4; ++pp)
#pragma unroll
            for (int dt = 0; dt < 4; ++dt) {
                const LAS unsigned char* a1 = vb + (32 * pp) * 128 + 32 * (dt ^ fvh);
                const s16x4 lo = __builtin_amdgcn_ds_read_tr16_b64_v4i16((LAS s16x4*)a1);
                const s16x4 hi = __builtin_amdgcn_ds_read_tr16_b64_v4i16((LAS s16x4*)(a1 + 16 * 128));
                bf16x8 Vf; Vf[0] = lo[0]; Vf[1] = lo[1]; Vf[2] = lo[2]; Vf[3] = lo[3]; Vf[4] = hi[0]; Vf[5] = hi[1]; Vf[6] = hi[2]; Vf[7] = hi[3];
                O[dt] = __builtin_amdgcn_mfma_f32_16x16x32_bf16(Vf, Pf[pp], O[dt], 0, 0, 0);
            }
#pragma unroll
        for (int dt = 0; dt < 4; ++dt) {
            const s16x4 v8 = __builtin_amdgcn_ds_read_tr16_b64_v4i16((LAS s16x4*)(vb + 128 * 128 + 32 * (dt ^ fvh)));
            O[dt] = __builtin_amdgcn_mfma_f32_16x16x16bf16_1k(v8, P8, O[dt], 0, 0, 0);
        }
        const float inv = fast_rcp(sum);
        bf16_t* orow = Ob + (rb + 64 * usel + qi) * 64;
#pragma unroll
        for (int dt = 0; dt < 4; ++dt) {
            u32x2 w; w.x = pg8::cvt_pk_bf16(O[dt][0] * inv, O[dt][1] * inv); w.y = pg8::cvt_pk_bf16(O[dt][2] * inv, O[dt][3] * inv);
            *(u32x2*)(orow + 16 * dt + 4 * fq) = w;
        }
        if (fq == 0) lse[(size_t)(b * SEQ + ((64 * n + qi) << dsh) + r) * NHEADS + hh] = mx + __builtin_amdgcn_logf(sum);
        buf ^= 1;
    }
    __syncthreads();
#undef ATT_DECODE
#undef ATT_ISSUE
}

__device__ __forceinline__ void elem_phase(const Ptrs& F, bf16_t* P, const bf16_t* Ob, const bf16_t* ZA, const float* lse, int vcu, int G) {
    int tid_ = threadIdx.x; asm volatile("" : "+v"(tid_));
    const int tid = tid_, lane = tid & 63, wave = tid >> 6;
    f32x4 cw[2][4][2];
#pragma unroll
    for (int ii = 0; ii < 2; ++ii) { const int ch = 8 * (lane + 64 * ii);
#pragma unroll
        for (int t = 0; t < 3; ++t) { cw[ii][t][0] = *(const f32x4*)(F.conv_w + t * DM + ch); cw[ii][t][1] = *(const f32x4*)(F.conv_w + t * DM + ch + 4); }
        cw[ii][3][0] = *(const f32x4*)(F.conv_b + ch); cw[ii][3][1] = *(const f32x4*)(F.conv_b + ch + 4); }
    for (int rb = vcu; rb < MP / 16; rb += G) {
        const int row = rb * 16 + 2 * wave, s = row & (SEQ - 1);
        bf16_t* pr = P + (size_t)row * NP; const int bb = row >> 12;
#pragma unroll
        for (int ii = 0; ii < 2; ++ii) {
            const int ch = 8 * (lane + 64 * ii);
            float bz0[8], bz1[8], um[8], u0[8], u1[8], u2[8];
            const u32x4 z4 = (u32x4){0u, 0u, 0u, 0u};
            unpack8(__builtin_nontemporal_load((const u32x4*)(pr + OFF_BZ + ch)), bz0); unpack8(__builtin_nontemporal_load((const u32x4*)(pr + NP + OFF_BZ + ch)), bz1);
            unpack8(*(const u32x4*)(pr + OFF_U + ch), u0); unpack8(*(const u32x4*)(pr + NP + OFF_U + ch), u1);
            unpack8(s > 0 ? *(const u32x4*)(pr - NP + OFF_U + ch) : z4, um); unpack8(s + 1 < SEQ - 1 ? *(const u32x4*)(pr + 2 * NP + OFF_U + ch) : z4, u2);
            f32x4 y0[2], y1[2];
#pragma unroll
            for (int j = 0; j < 8; ++j) {
                const float w0 = cw[ii][0][j >> 2][j & 3], w1 = cw[ii][1][j >> 2][j & 3], w2 = cw[ii][2][j >> 2][j & 3], cb = cw[ii][3][j >> 2][j & 3];
                y0[j >> 2][j & 3] = bz0[j] * (um[j] * w0 + u0[j] * w1 + u1[j] * w2 + cb);
                y1[j >> 2][j & 3] = bz1[j] * (u0[j] * w0 + u1[j] * w1 + u2[j] * w2 + cb);
            }
            *(u32x4*)(pr + OFF_YC + ch) = pack8(y0[0], y0[1]);
            *(u32x4*)(pr + NP + OFF_YC + ch) = pack8(y1[0], y1[1]);
        }
        {
            const int h = lane >> 3, dc = (lane & 7) * 8;
#pragma unroll
            for (int rr = 0; rr < 2; ++rr) {
                const int sr = s + rr;
                const float* lp = lse + (size_t)(row + rr) * NHEADS + h;
                const float L0 = lp[0], L1 = lp[8], L2 = lp[16];
                const float mx = fmaxf(L0, fmaxf(L1, L2));
                float w0 = fast_exp2(L0 - mx), w1 = fast_exp2(L1 - mx), w2 = fast_exp2(L2 - mx);
                const float inv = fast_rcp(w0 + w1 + w2); w0 *= inv; w1 *= inv; w2 *= inv;
                float o0[8], o1[8], o2[8], za[8];
                const bf16_t* ob = Ob + ((size_t)(bb * NHEADS + h) * SEQ) * 64 + dc;
                unpack8(__builtin_nontemporal_load((const u32x4*)(ob + (size_t)sr * 64)), o0);
                unpack8(__builtin_nontemporal_load((const u32x4*)(ob + ((size_t)8 * SEQ + ((sr & 3) << 10) + (sr >> 2)) * 64)), o1);
                unpack8(__builtin_nontemporal_load((const u32x4*)(ob + ((size_t)16 * SEQ + ((sr & 15) << 8) + (sr >> 4)) * 64)), o2);
                unpack8(*(const u32x4*)(pr + rr * NP + OFF_ZA + h * 64 + dc), za);
                f32x4 y[2];
#pragma unroll
                for (int j = 0; j < 8; ++j) y[j >> 2][j & 3] = (w0 * o0[j] + w1 * o1[j] + w2 * o2[j]) * siluf_(za[j]);
                *(u32x4*)(pr + rr * NP + OFF_YA + h * 64 + dc) = pack8(y[0], y[1]);
            }
        }
    }
}

#define XB_TMO      128
#define XB_XCNT(j)  (256  + 64 * (j))
#define XB_XSUB(j)  (1280 + 64 * (j))
#define XB_XGEN(j)  (2304 + 64 * (j))
#define XB_TOP      3328
#define XB_TOPGEN   3392
#define XCD_BAR_WORDS 3456
#define XB_SPIN_CAP (1u << 18)

__device__ __forceinline__ unsigned xb_ld(unsigned* p)              { return __hip_atomic_load(p, __ATOMIC_RELAXED, __HIP_MEMORY_SCOPE_AGENT); }
__device__ __forceinline__ unsigned xb_add(unsigned* p, unsigned v) { return __hip_atomic_fetch_add(p, v, __ATOMIC_RELAXED, __HIP_MEMORY_SCOPE_AGENT); }
__device__ __forceinline__ unsigned xb_xcc_id() { return (unsigned)__builtin_amdgcn_s_getreg((3 << 11) | 20) & 0xFu; }
#define XB_SPIN(cond, bar) do { unsigned _sp = 0; while (cond) { __builtin_amdgcn_s_sleep(1); \
    if ((++_sp & 255u) == 0u) { if (xb_ld(&(bar)[XB_TMO])) break; if (_sp > XB_SPIN_CAP) { atomicAdd(&(bar)[XB_TMO], 1u); break; } } } } while (0)

struct XcdBarrier {
    unsigned* bar; unsigned x;
    volatile LAS unsigned* st;
};

__device__ __forceinline__ XcdBarrier xcd_barrier_post(unsigned* bar, volatile LAS unsigned* st) {
    XcdBarrier b; b.bar = bar; b.x = xb_xcc_id(); b.st = st;
    if (threadIdx.x == 0) (void)xb_add(&bar[XB_XCNT(b.x)], 1u);
    return b;
}
__device__ __forceinline__ void xcd_barrier_complete(unsigned* bar, unsigned x, unsigned& nloc, unsigned& nx) {
    const unsigned G = gridDim.x * gridDim.y * gridDim.z;
    unsigned sum, cnt, mine, sp = 0u;
    for (;;) {
        sum = 0u; cnt = 0u; mine = 0u;
#pragma unroll
        for (unsigned j = 0; j < 16; ++j) { const unsigned c = xb_ld(&bar[XB_XCNT(j)]); sum += c; cnt += (c > 0u) ? 1u : 0u; mine = (j == x) ? c : mine; }
        if (sum == G) break;
        __builtin_amdgcn_s_sleep(1);
        if ((++sp & 255u) == 0u) { if (xb_ld(&bar[XB_TMO])) break; if (sp > XB_SPIN_CAP) { atomicAdd(&bar[XB_TMO], 1u); break; } }
    }
    nloc = mine > 0u ? mine : 1u; nx = cnt > 0u ? cnt : 1u;
}

__device__ __forceinline__ void xcd_barrier(const XcdBarrier& b) {
    asm volatile("s_waitcnt vmcnt(0)" ::: "memory");
    __syncthreads();
    if (threadIdx.x == 0) {
        unsigned* bar = b.bar;
        __builtin_amdgcn_s_waitcnt(0);
        unsigned nloc = b.st[0], nx = b.st[1];
        if (nloc == 0u) { xcd_barrier_complete(bar, b.x, nloc, nx); b.st[0] = nloc; b.st[1] = nx; }
        const unsigned old = xb_add(&bar[XB_XSUB(b.x)], 1u);
        const unsigned gen = old / nloc;
        if (old + 1u == (gen + 1u) * nloc) {
            __builtin_amdgcn_fence(__ATOMIC_RELEASE, "agent");
            asm volatile("s_waitcnt vmcnt(0)" ::: "memory");
            const unsigned og = xb_add(&bar[XB_TOP], 1u);
            const unsigned tg = og / nx;
            if (og + 1u == (tg + 1u) * nx) xb_add(&bar[XB_TOPGEN], 1u);
            else XB_SPIN(xb_ld(&bar[XB_TOPGEN]) == tg, bar);
            __builtin_amdgcn_fence(__ATOMIC_ACQUIRE, "agent");
            xb_add(&bar[XB_XGEN(b.x)], 1u);
            asm volatile("s_waitcnt vmcnt(0)" ::: "memory");
        } else {
            XB_SPIN(xb_ld(&bar[XB_XGEN(b.x)]) == gen, bar);
            __builtin_amdgcn_fence(__ATOMIC_ACQUIRE, "agent");
            asm volatile("s_waitcnt vmcnt(0)" ::: "memory");
        }
    }
    __syncthreads();
}


struct Args { const float* in[10]; float* out; unsigned char* ws; int pad0, pad1; };

__global__ void __launch_bounds__(NTHREADS, 2) fwd_kernel(Args args) {
    extern __shared__ __attribute__((aligned(16))) unsigned char lds_raw[];
    LAS unsigned char* lds = (LAS unsigned char*)lds_raw;
    cg::grid_group grid = cg::this_grid();
    const int G = gridDim.x, bx = blockIdx.x;
    const int vcu = (G % 8 == 0) ? (bx % 8) * (G / 8) + bx / 8 : bx;
    unsigned char* ws = args.ws;
    Ptrs F;
    F.x = args.in[0]; F.norm_g = args.in[1]; F.w_in = args.in[2]; F.conv_w = args.in[3]; F.conv_b = args.in[4]; F.qg = args.in[5]; F.kg = args.in[6];
    F.wbc = args.in[7]; F.wba = args.in[8]; F.wout = args.in[9]; F.out = args.out;
    F.WinT = (bf16_t*)(ws + WS_WIN); F.WcatT = (bf16_t*)(ws + WS_WCAT); F.WoutT = (bf16_t*)(ws + WS_WOUT);
    F.XN = (bf16_t*)args.out;
    F.PROJ = (bf16_t*)(ws + WS_PROJ); F.Mb = F.PROJ + OFF_U; F.Qb = (bf16_t*)(ws + WS_Q); F.Kb = (bf16_t*)(ws + WS_K); F.Vb = (bf16_t*)(ws + WS_V); F.ZA = (bf16_t*)(ws + WS_ZA);
    F.rope = (float*)(ws + WS_ROPE); F.lse = (float*)(ws + WS_LSE);
    unsigned* barw = (unsigned*)(ws + WS_BAR);
    volatile LAS unsigned* st = (volatile LAS unsigned*)(lds + 131072);
    if (threadIdx.x < 64) st[threadIdx.x] = 0u;
    __syncthreads();
    XcdBarrier xbar = xcd_barrier_post(barw, st);
    if (args.pad0 != 0) grid.sync();

    prologue(F, lds, vcu, G);
    xcd_barrier(xbar);

    bf16_t* GC = (bf16_t*)(ws + WS_GC); bf16_t* GA = (bf16_t*)(ws + WS_GA);
    EpiProj EP{F.PROJ, F.Qb, F.ZA, GC, F.qg, F.kg, F.rope};
    if (((bx >> 3) & 1) != 0) late_transposes(F, lds, ((((bx >> 4) << 3) | (bx & 7)) * NWAVES) + (threadIdx.x >> 6), (G >> 1) * NWAVES);
    {
        pg8::Gemm g{F.XN, F.WinT, DM, DM, DM}; pg8::StaticOrder S; S.init(MP, 36 * 256, G, bx, 0);
        pg8::gemm_phase<EpiProj, pg8::StaticOrder>(lds, g, S, EP);
    }
    xcd_barrier(xbar);
    attn_phase(lds, F.Qb, F.Kb, F.Vb, F.Qb, F.lse, vcu, G);
    xcd_barrier(xbar);
    const bool elem_first = ((bx >> 3) & 1) != 0;
    if (elem_first) elem_phase(F, F.PROJ, F.Qb, F.ZA, F.lse, vcu, G);
    {
        pg8::Gemm g{F.XN, F.WinT, DM, DM, DM};
        pg8::StaticOrder S2; S2.init(MP, 8 * 256, G, bx, 36);
        pg8::gemm_phase<EpiProj, pg8::StaticOrder>(lds, g, S2, EP);
    }
    if (!elem_first) elem_phase(F, F.PROJ, F.Qb, F.ZA, F.lse, vcu, G);
    xcd_barrier(xbar);
    {
        pg8::Gemm g{F.PROJ, F.WcatT, NP, 1536, 1536}; pg8::StaticOrder S; S.init(MP, DM, G, bx);
        EpiMerge E{GC, GA, F.Mb};
        pg8::gemm_phase<EpiMerge, pg8::StaticOrder>(lds, g, S, E);
    }
    xcd_barrier(xbar);
    {
        pg8::Gemm g{F.Mb, F.WoutT, NP, DM, DM}; pg8::StaticOrder S; S.init(MP, DM, G, bx);
        EpiOut E{F.x, F.out};
        pg8::gemm_phase<EpiOut, pg8::StaticOrder>(lds, g, S, E);
    }
}

extern "C" void kernel_launch(void* const* d_in, const int* in_sizes, int n_in, void* d_out, int out_size, void* d_ws, size_t ws_size, hipStream_t stream) {
    static int grid = 0;
    if (grid == 0) {
        if (n_in != 10 || in_sizes[0] != MTOT * DM || out_size != MTOT * DM || ws_size < WS_END) {
            fprintf(stderr, "kernel_launch: unexpected shapes (n_in %d, in0 %d, out %d, ws %zu)\n", n_in, n_in > 0 ? in_sizes[0] : -1, out_size, ws_size); grid = -1; return; }
        int dev = 0, cus = 0, per_cu = 0;
        hipGetDevice(&dev);
        hipDeviceGetAttribute(&cus, hipDeviceAttributeMultiprocessorCount, dev);
        if (hipFuncSetAttribute((const void*)fwd_kernel, hipFuncAttributeMaxDynamicSharedMemorySize, LDS_BYTES) != hipSuccess) { fprintf(stderr, "kernel_launch: hipFuncSetAttribute failed\n"); grid = -1; return; }
        if (hipOccupancyMaxActiveBlocksPerMultiprocessor(&per_cu, (const void*)fwd_kernel, NTHREADS, LDS_BYTES) != hipSuccess || per_cu < 1) { fprintf(stderr, "kernel_launch: occupancy query failed (%d)\n", per_cu); per_cu = 1; }
        (void)hipGetLastError();
        grid = cus * per_cu;
    }
    if (grid < 0) return;
    if (hipMemsetAsync((char*)d_ws + WS_BAR, 0, XCD_BAR_WORDS * 4, stream) != hipSuccess) { fprintf(stderr, "kernel_launch: memset failed\n"); return; }
    Args a{};
    for (int i = 0; i < 10; ++i) a.in[i] = (const float*)d_in[i];
    a.out = (float*)d_out; a.ws = (unsigned char*)d_ws;
    void* kargs[] = {&a};
    hipError_t e = hipLaunchCooperativeKernel((const void*)fwd_kernel, dim3(grid), dim3(NTHREADS), kargs, LDS_BYTES, stream);
    if (e != hipSuccess) fprintf(stderr, "cooperative launch failed: %s (grid %d)\n", hipGetErrorString(e), grid);
}
```

```cpp
#include <hip/hip_runtime.h>
#include <hip/hip_cooperative_groups.h>
#include <cstdio>
#include <cstdint>
namespace cg = cooperative_groups;

#define LAS __attribute__((address_space(3)))
typedef unsigned short bf16_t;
typedef short bf16x8 __attribute__((ext_vector_type(8)));
typedef short s16x4 __attribute__((ext_vector_type(4)));
typedef float f32x4 __attribute__((ext_vector_type(4)));
typedef unsigned u32x4 __attribute__((ext_vector_type(4)));
typedef unsigned u32x2 __attribute__((ext_vector_type(2)));

constexpr int SEQ = 4096, DM = 1024, NBATCH = 8, MTOT = NBATCH * SEQ;
constexpr int MP = MTOT;
constexpr int NIN = 11264;
constexpr int NP = 2560;
constexpr int OFF_ZA = 0, OFF_BZ = 512, OFF_U = 1536;
constexpr int OFF_YA = OFF_ZA, OFF_YC = OFF_BZ;
constexpr int NHEADS = 24;
constexpr float NORM_EPS = 1e-6f;
constexpr float QSCALE = 0.125f * 1.4426950408889634f;

constexpr size_t MiB = 1u << 20;
constexpr size_t WS_WIN = 0;
constexpr size_t WS_WCAT = 22 * MiB;
constexpr size_t WS_WOUT = 25 * MiB;
constexpr size_t WS_ROPE = 27 * MiB;
constexpr size_t WS_LSE = 28 * MiB;
constexpr size_t WS_BAR = 31 * MiB;
constexpr size_t WS_Q = 32 * MiB;
constexpr size_t WS_K = 128 * MiB;
constexpr size_t WS_V = 224 * MiB;
constexpr size_t WS_GC = 128 * MiB;
constexpr size_t WS_GA = 192 * MiB;
constexpr size_t WS_PROJ = 320 * MiB;
constexpr size_t WS_ZA = 480 * MiB;
constexpr size_t WS_END = 480 * MiB;

static_assert(WS_V - WS_K == WS_K - WS_Q, "q/k/v spacing");
constexpr int NWAVES = 8, NTHREADS = 512;
constexpr int LDS_BYTES = 131072 + 1024;

namespace pg8 {
constexpr int BM = 256, BK = 64, HALF = 128, HTB = HALF * BK * 2, NXCD = 8, WGM = 8;
__host__ __device__ __forceinline__ int lds_byte(int r, int c) { const int st = (r >> 4) * 2 + (c >> 5), rr = r & 15, cc = c & 31, ob = rr * 64 + cc * 2; return st * 1024 + (ob ^ (((ob >> 9) & 1) << 5)); }
__host__ __device__ __forceinline__ void stage_rc(int b, int& R, int& C) { const int st = b / 1024, sb = b % 1024, swz = sb ^ (((sb >> 9) & 1) << 5); R = (st >> 1) * 16 + swz / 64; C = (st & 1) * 32 + (swz % 64) / 2; }
__host__ __device__ __forceinline__ int perm32(int rho) { const int n = rho >> 4, i = rho & 15; return 8 * (i >> 2) + 4 * n + (i & 3); }

struct Unit { int pm, pn; };
struct Gemm { const bf16_t* A; const bf16_t* Bt; int lda, ldb, K; };

struct StaticOrder {
    int nM, nN, nwg, G, c, pn0;
    __device__ void init(int M, int N, int G_, int c_, int pn0_ = 0) { nM = M / BM; nN = N / BM; nwg = nM * nN; G = G_; c = c_; pn0 = pn0_; }
    __device__ bool next(int i, Unit& u) const {
        const long L = (long)i * G + c; if (L >= nwg) return false;
        int wgid = (int)L; { const int q = nwg / NXCD, r = nwg % NXCD, xcd = wgid % NXCD, off = wgid / NXCD; wgid = (xcd < r ? xcd * (q + 1) : r * (q + 1) + (xcd - r) * q) + off; }
        const int nig = WGM * nN, gid = wgid / nig, fm = gid * WGM, gsz = (nM - fm) < WGM ? (nM - fm) : WGM;
        u.pm = fm + ((wgid % nig) % gsz); u.pn = pn0 + (wgid % nig) / gsz; return true;
    }
};

__device__ __forceinline__ unsigned cvt_pk_bf16(float lo, float hi) { unsigned r; asm volatile("v_cvt_pk_bf16_f32 %0, %1, %2" : "=v"(r) : "v"(lo), "v"(hi)); return r; }

template <class Epi, class Sched>
__device__ __forceinline__ void gemm_phase(LAS unsigned char* lds, const Gemm g, const Sched& S, const Epi& E) {
    int tid_ = threadIdx.x; asm volatile("" : "+v"(tid_));
    const int tid = tid_, wid = __builtin_amdgcn_readfirstlane(tid >> 6), lane = tid & 63, wr = wid >> 2, wc = wid & 3, fr = lane & 15, fq = lane >> 4;
    const int K = g.K, nt = K / BK;
    unsigned voffA[2], voffB[2];
#pragma unroll
    for (int i = 0; i < 2; ++i) { int R, C; stage_rc(tid * 16 + i * 8192, R, C); const int Rb = (R & ~31) + perm32(R & 31);
        voffA[i] = (unsigned)(R * g.lda + C) * 2u; voffB[i] = (unsigned)(Rb * g.ldb + C) * 2u; }
    const size_t kstep = (size_t)(BK * 2);
    const size_t hstepA = (size_t)HALF * g.lda * 2, hstepB = (size_t)HALF * g.ldb * 2;
    const size_t tstepA = 2 * hstepA, tstepB = 2 * hstepB;
    const unsigned ldsw = (unsigned)wid * 1024u;
    const int aoff = lds_byte(wr * 64 + fr, fq * 8), boff = lds_byte(wc * 32 + fr, fq * 8);
#define PG8_SA(b, h) (((b) * 2 + (h)) * HTB)
#define PG8_SB(b, h) ((4 + (b) * 2 + (h)) * HTB)
#define PG8_STAGE(bufoff, gbase, voff) do { _Pragma("unroll") for (int _i = 0; _i < 2; ++_i) \
        __builtin_amdgcn_global_load_lds((const unsigned*)((const char*)(gbase) + (voff)[_i]), (LAS unsigned*)(lds + (bufoff) + ldsw + _i * 8192), 16, 0, 0); } while (0)
#define PG8_LDA(dst, b, h) do { _Pragma("unroll") for (int m = 0; m < 4; ++m) _Pragma("unroll") for (int k = 0; k < 2; ++k) dst[m][k] = *(const LAS bf16x8*)(lds + PG8_SA(b, h) + aoff + m * 2048 + k * 1024); } while (0)
#define PG8_LDB(dst, b, h) do { _Pragma("unroll") for (int n = 0; n < 2; ++n) _Pragma("unroll") for (int k = 0; k < 2; ++k) dst[n][k] = *(const LAS bf16x8*)(lds + PG8_SB(b, h) + boff + n * 2048 + k * 1024); } while (0)
#define PG8_MMA(ai, bj, At, Bt) do { __builtin_amdgcn_s_setprio(1); _Pragma("unroll") for (int m = 0; m < 4; ++m) _Pragma("unroll") for (int n = 0; n < 2; ++n) _Pragma("unroll") for (int k = 0; k < 2; ++k) \
        acc[ai][bj][m][n] = __builtin_amdgcn_mfma_f32_16x16x32_bf16(Bt[n][k], At[m][k], acc[ai][bj][m][n], 0, 0, 0); __builtin_amdgcn_s_setprio(0); } while (0)
#define PG8_WAIT_V(n) asm volatile("s_waitcnt vmcnt(" #n ")" ::: "memory")
#define PG8_WAIT_L(n) asm volatile("s_waitcnt lgkmcnt(" #n ")" ::: "memory")
#define PG8_BAR __builtin_amdgcn_s_barrier()
#define PG8_SCHED __builtin_amdgcn_sched_barrier(0)
    Unit cur, nxt; int ui = 0;
    if (!S.next(0, cur)) return;
    f32x4 acc[2][2][4][2];
#pragma unroll
    for (int a = 0; a < 2; ++a)
#pragma unroll
        for (int b = 0; b < 2; ++b)
#pragma unroll
            for (int m = 0; m < 4; ++m)
#pragma unroll
                for (int n = 0; n < 2; ++n) acc[a][b][m][n] = (f32x4){0.f, 0.f, 0.f, 0.f};
    bf16x8 At[4][2], B0[2][2], B1[2][2];
    const char* cA = (const char*)g.A + (size_t)cur.pm * tstepA; const char* cB = (const char*)g.Bt + (size_t)cur.pn * tstepB;
    PG8_STAGE(PG8_SB(0, 0), cB, voffB); PG8_STAGE(PG8_SB(0, 1), cB + hstepB, voffB); PG8_STAGE(PG8_SA(0, 0), cA, voffA); PG8_STAGE(PG8_SA(0, 1), cA + hstepA, voffA);
    if (wr == 1) PG8_BAR;
    PG8_WAIT_V(2); PG8_BAR;
    PG8_STAGE(PG8_SB(1, 0), cB + kstep, voffB); PG8_STAGE(PG8_SA(1, 0), cA + kstep, voffA); PG8_STAGE(PG8_SB(1, 1), cB + hstepB + kstep, voffB);
    PG8_WAIT_V(6); PG8_BAR;
    for (;;) {
        const bool has_next = S.next(ui + 1, nxt);
        const char* nA = has_next ? (const char*)g.A + (size_t)nxt.pm * tstepA : cA; const char* nB = has_next ? (const char*)g.Bt + (size_t)nxt.pn * tstepB : cB;
        for (int t = 0; t < nt; t += 2) {
            const bool last = (t == nt - 2);
            const char* a1 = cA + (size_t)(t + 1) * kstep;
            const char* a2 = last ? nA : cA + (size_t)(t + 2) * kstep; const char* b2 = last ? nB : cB + (size_t)(t + 2) * kstep;
            const char* a3 = a2 + kstep; const char* b3 = b2 + kstep;
            if constexpr (Epi::MIDK > 0) { if (t == Epi::MIDK) E.mid(acc, cur, wr, wc, fr, fq); }
            PG8_LDB(B0, 0, 0); PG8_LDB(B1, 0, 1); PG8_SCHED; PG8_LDA(At, 0, 0); PG8_STAGE(PG8_SA(1, 1), a1 + hstepA, voffA);
            PG8_WAIT_V(8); PG8_WAIT_L(0); PG8_BAR; PG8_MMA(0, 0, At, B0); PG8_MMA(0, 1, At, B1); PG8_BAR; PG8_SCHED;
            PG8_LDA(At, 0, 1); PG8_STAGE(PG8_SB(0, 0), b2, voffB); PG8_STAGE(PG8_SB(0, 1), b2 + hstepB, voffB); PG8_STAGE(PG8_SA(0, 0), a2, voffA);
            PG8_WAIT_V(8); PG8_WAIT_L(0); PG8_BAR; PG8_MMA(1, 0, At, B0); PG8_MMA(1, 1, At, B1); PG8_BAR; PG8_SCHED;
            PG8_LDB(B0, 1, 0); PG8_LDB(B1, 1, 1); PG8_SCHED; PG8_LDA(At, 1, 0); PG8_STAGE(PG8_SA(0, 1), a2 + hstepA, voffA);
            PG8_WAIT_V(8); PG8_WAIT_L(0); PG8_BAR; PG8_MMA(0, 0, At, B0); PG8_MMA(0, 1, At, B1); PG8_BAR; PG8_SCHED;
            PG8_LDA(At, 1, 1); PG8_STAGE(PG8_SB(1, 0), b3, voffB); PG8_STAGE(PG8_SB(1, 1), b3 + hstepB, voffB); PG8_STAGE(PG8_SA(1, 0), a3, voffA);
            PG8_WAIT_V(8); PG8_WAIT_L(0); PG8_BAR; PG8_MMA(1, 0, At, B0); PG8_MMA(1, 1, At, B1); PG8_BAR; PG8_SCHED;
        }
        if (wr == 0) PG8_BAR;
        E(acc, cur, wr, wc, fr, fq);
        if (!has_next) break;
#pragma unroll
        for (int a = 0; a < 2; ++a)
#pragma unroll
            for (int b = 0; b < 2; ++b)
#pragma unroll
                for (int m = 0; m < 4; ++m)
#pragma unroll
                    for (int n = 0; n < 2; ++n) acc[a][b][m][n] = (f32x4){0.f, 0.f, 0.f, 0.f};
        cur = nxt; cA = nA; cB = nB; ++ui;
        if (wr == 1) PG8_BAR;
    }
    PG8_WAIT_V(0);
    PG8_BAR;
#undef PG8_SA
#undef PG8_SB
#undef PG8_STAGE
#undef PG8_LDA
#undef PG8_LDB
#undef PG8_MMA
#undef PG8_WAIT_V
#undef PG8_WAIT_L
#undef PG8_BAR
#undef PG8_SCHED
}
}

__device__ __forceinline__ float bf_lo(unsigned w) { return __uint_as_float(w << 16); }
__device__ __forceinline__ float bf_hi(unsigned w) { return __uint_as_float(w & 0xffff0000u); }
__device__ __forceinline__ float fast_rcp(float x) { return __builtin_amdgcn_rcpf(x); }
__device__ __forceinline__ float fast_exp2(float x) { return __builtin_amdgcn_exp2f(x); }
__device__ __forceinline__ float sigmoidf_(float x) { return fast_rcp(1.f + fast_exp2(-1.4426950408889634f * x)); }
__device__ __forceinline__ float siluf_(float x) { return x * sigmoidf_(x); }
__device__ __forceinline__ u32x4 pack8(const f32x4 a, const f32x4 b) {
    u32x4 w; w.x = pg8::cvt_pk_bf16(a[0], a[1]); w.y = pg8::cvt_pk_bf16(a[2], a[3]); w.z = pg8::cvt_pk_bf16(b[0], b[1]); w.w = pg8::cvt_pk_bf16(b[2], b[3]); return w;
}
__device__ __forceinline__ void unpack8(const u32x4 w, float (&f)[8]) {
    f[0] = bf_lo(w.x); f[1] = bf_hi(w.x); f[2] = bf_lo(w.y); f[3] = bf_hi(w.y); f[4] = bf_lo(w.z); f[5] = bf_hi(w.z); f[6] = bf_lo(w.w); f[7] = bf_hi(w.w);
}
__device__ __forceinline__ float wave_sum(float v) {
#pragma unroll
    for (int o = 1; o < 64; o <<= 1) v += __shfl_xor(v, o);
    return v;
}

struct EpiProj {
    static constexpr int MIDK = 0;
    bf16_t* P; bf16_t* Qb; bf16_t* ZA; bf16_t* GCp; const float* qg; const float* kg; const float* rope;
    __device__ __forceinline__ void operator()(const f32x4 (&acc)[2][2][4][2], const pg8::Unit& u, int wr, int wc, int fr, int fq) const {
        const int pn = u.pn;
        const int row0 = u.pm * 256 + wr * 64 + fr;
        if (pn >= 16 && pn < 34) {
            const int sel = pn < 22 ? 0 : (pn < 28 ? 1 : 2);
            const int hh = (pn - 16 - 6 * sel) * 4 + wc, dsh = 2 * (hh >> 3);
            bf16_t* base = Qb + (size_t)sel * ((WS_K - WS_Q) / 2) + (size_t)hh * (SEQ * 64) + 8 * fq;
            if (sel < 2) {
                const float* gp = sel == 0 ? qg : kg;
                const float sc = sel == 0 ? QSCALE : 1.f;
                const f32x4 g00 = *(const f32x4*)(gp + 8 * fq), g01 = *(const f32x4*)(gp + 8 * fq + 4), g10 = *(const f32x4*)(gp + 32 + 8 * fq), g11 = *(const f32x4*)(gp + 36 + 8 * fq);
#pragma unroll
                for (int ai = 0; ai < 2; ++ai)
#pragma unroll
                    for (int m = 0; m < 4; ++m) {
                        float ss = 0.f;
#pragma unroll
                        for (int bj = 0; bj < 2; ++bj)
#pragma unroll
                            for (int n = 0; n < 2; ++n) { const f32x4 x = acc[ai][bj][m][n]; ss += (x[0] * x[0] + x[1] * x[1]) + (x[2] * x[2] + x[3] * x[3]); }
                        ss += __shfl_xor(ss, 16); ss += __shfl_xor(ss, 32);
                        const float rinv = rsqrtf(ss * (1.f / 64.f) + NORM_EPS) * sc;
                        const int row = row0 + ai * 128 + m * 16, pos = row & (SEQ - 1), bb = row >> 12;
                        const int p = ((pos & ((1 << dsh) - 1)) << (12 - dsh)) + (pos >> dsh);
                        const float* rp = rope + pos * 64 + 8 * fq;
                        f32x4 o1[2], o2[2];
#pragma unroll
                        for (int n = 0; n < 2; ++n) {
                            const f32x4 c = *(const f32x4*)(rp + 4 * n), sn = *(const f32x4*)(rp + 32 + 4 * n);
                            const f32x4 t1 = acc[ai][0][m][n] * rinv * (n == 0 ? g00 : g01), t2 = acc[ai][1][m][n] * rinv * (n == 0 ? g10 : g11);
                            o1[n] = t1 * c - t2 * sn; o2[n] = t2 * c + t1 * sn;
                        }
                        bf16_t* dst = base + ((size_t)bb * (NHEADS * SEQ) + p) * 64;
                        __builtin_nontemporal_store(pack8(o1[0], o1[1]), (u32x4*)dst);
                        __builtin_nontemporal_store(pack8(o2[0], o2[1]), (u32x4*)(dst + 32));
                    }
            } else {
#pragma unroll
                for (int ai = 0; ai < 2; ++ai)
#pragma unroll
                    for (int m = 0; m < 4; ++m) {
                        const int row = row0 + ai * 128 + m * 16, pos = row & (SEQ - 1), bb = row >> 12;
                        const int p = ((pos & ((1 << dsh) - 1)) << (12 - dsh)) + (pos >> dsh);
                        bf16_t* dst = base + ((size_t)bb * (NHEADS * SEQ) + p) * 64;
                        __builtin_nontemporal_store(pack8(acc[ai][0][m][0], acc[ai][0][m][1]), (u32x4*)dst);
                        __builtin_nontemporal_store(pack8(acc[ai][1][m][0], acc[ai][1][m][1]), (u32x4*)(dst + 32));
                    }
            }
        } else {
            if (pn < 16) {
                const bool isu = pn < 8;
                const int cb = (isu ? OFF_U : OFF_BZ) + 128 * (pn & 7) + 32 * wc + 8 * fq;
#pragma unroll
                for (int ai = 0; ai < 2; ++ai)
#pragma unroll
                    for (int m = 0; m < 4; ++m) {
                        f32x4 v0 = acc[ai][0][m][0], v1 = acc[ai][0][m][1];
                        const f32x4 y0 = acc[ai][1][m][0], y1 = acc[ai][1][m][1];
                        if (isu) { v0 *= y0; v1 *= y1; }
                        else {
#pragma unroll
                            for (int j = 0; j < 4; ++j) { v0[j] *= siluf_(y0[j]); v1[j] *= siluf_(y1[j]); }
                        }
                        __builtin_nontemporal_store(pack8(v0, v1), (u32x4*)(P + (size_t)(row0 + ai * 128 + m * 16) * NP + cb));
                    }
            } else {
                if (pn >= 36) {
                    const int gcol = 128 * (pn - 36) + 32 * wc + 8 * fq;
#pragma unroll
                    for (int ai = 0; ai < 2; ++ai)
#pragma unroll
                        for (int m = 0; m < 4; ++m) {
                            const size_t go = (size_t)(row0 + ai * 128 + m * 16) * 1024 + gcol;
                            f32x4 sc[2], rho[2];
#pragma unroll
                            for (int n = 0; n < 2; ++n)
#pragma unroll
                                for (int j = 0; j < 4; ++j) {
                                    const float ec = fminf(fast_exp2(-1.4426950408889634f * acc[ai][0][m][n][j]), 1e30f), ea = fast_exp2(-1.4426950408889634f * acc[ai][1][m][n][j]);
                                    sc[n][j] = fast_rcp(1.f + ec); rho[n][j] = (1.f + ec) * fast_rcp(1.f + ea);
                                }
                            *(u32x4*)(GCp + go) = pack8(sc[0], sc[1]);
                            *(u32x4*)(GCp + (WS_GA - WS_GC) / 2 + go) = pack8(rho[0], rho[1]);
                        }
                    return;
                }
                bf16_t* base = P + OFF_ZA + (pn - 34) * 256 + wc * 64 + 8 * fq;
#pragma unroll
                for (int ai = 0; ai < 2; ++ai)
#pragma unroll
                    for (int m = 0; m < 4; ++m) {
                        bf16_t* dst = base + (size_t)(row0 + ai * 128 + m * 16) * NP;
                        __builtin_nontemporal_store(pack8(acc[ai][0][m][0], acc[ai][0][m][1]), (u32x4*)dst);
                        __builtin_nontemporal_store(pack8(acc[ai][1][m][0], acc[ai][1][m][1]), (u32x4*)(dst + 32));
                    }
            }
        }
    }
};

struct EpiGate {
    static constexpr int MIDK = 0;
    bf16_t* Gx;
    __device__ __forceinline__ void operator()(const f32x4 (&acc)[2][2][4][2], const pg8::Unit& u, int wr, int wc, int fr, int fq) const {
        const int row0 = u.pm * 256 + wr * 64 + fr, col0 = u.pn * 256 + wc * 32 + 8 * fq;
#pragma unroll
        for (int ai = 0; ai < 2; ++ai)
#pragma unroll
            for (int m = 0; m < 4; ++m) {
                bf16_t* dst = Gx + (size_t)(row0 + ai * 128 + m * 16) * 1024 + col0;
#pragma unroll
                for (int bj = 0; bj < 2; ++bj) {
                    f32x4 v0 = acc[ai][bj][m][0], v1 = acc[ai][bj][m][1];
#pragma unroll
                    for (int j = 0; j < 4; ++j) { v0[j] = sigmoidf_(v0[j]); v1[j] = sigmoidf_(v1[j]); }
                    *(u32x4*)(dst + bj * 128) = pack8(v0, v1);
                }
            }
    }
};

struct EpiMerge {
    static constexpr int MIDK = 8;
    const bf16_t* GC; const bf16_t* GA; bf16_t* Mb;
    __device__ __forceinline__ void mid(f32x4 (&acc)[2][2][4][2], const pg8::Unit& u, int wr, int wc, int fr_, int fq_) const {
        int fr = fr_, fq = fq_; asm volatile("" : "+v"(fr), "+v"(fq));
        const int row0 = u.pm * 256 + wr * 64 + fr, col0 = u.pn * 256 + wc * 32 + 8 * fq;
#pragma unroll
        for (int ai = 0; ai < 2; ++ai)
#pragma unroll
            for (int m = 0; m < 4; ++m) {
                const size_t go = (size_t)(row0 + ai * 128 + m * 16) * 1024 + col0;
#pragma unroll
                for (int bj = 0; bj < 2; ++bj) {
                    float rh[8]; unpack8(__builtin_nontemporal_load((const u32x4*)(GA + go + bj * 128)), rh);
#pragma unroll
                    for (int j = 0; j < 4; ++j) { acc[ai][bj][m][0][j] *= rh[j]; acc[ai][bj][m][1][j] *= rh[4 + j]; }
                }
                __builtin_amdgcn_sched_barrier(0);
            }
    }
    __device__ __forceinline__ void operator()(const f32x4 (&acc)[2][2][4][2], const pg8::Unit& u, int wr, int wc, int fr, int fq) const {
        const int row0 = u.pm * 256 + wr * 64 + fr, col0 = u.pn * 256 + wc * 32 + 8 * fq;
#pragma unroll
        for (int ai = 0; ai < 2; ++ai) {
            u32x4 g[4][2];
#pragma unroll
            for (int m = 0; m < 4; ++m)
#pragma unroll
                for (int bj = 0; bj < 2; ++bj) g[m][bj] = *(const u32x4*)(GC + (size_t)(row0 + ai * 128 + m * 16) * 1024 + col0 + bj * 128);
            __builtin_amdgcn_sched_barrier(0);
#pragma unroll
            for (int m = 0; m < 4; ++m) {
                const int row = row0 + ai * 128 + m * 16;
#pragma unroll
                for (int bj = 0; bj < 2; ++bj) {
                    const int col = col0 + bj * 128;
                    float gc[8]; unpack8(g[m][bj], gc);
                    f32x4 v0 = acc[ai][bj][m][0], v1 = acc[ai][bj][m][1];
#pragma unroll
                    for (int j = 0; j < 4; ++j) { v0[j] *= gc[j]; v1[j] *= gc[4 + j]; }
                    *(u32x4*)(Mb + (size_t)row * NP + col) = pack8(v0, v1);
                }
            }
            __builtin_amdgcn_sched_barrier(0);
        }
    }
};

struct EpiOut {
    static constexpr int MIDK = 0;
    const float* X; float* O;
    __device__ __forceinline__ void operator()(const f32x4 (&acc)[2][2][4][2], const pg8::Unit& u, int wr, int wc, int fr, int fq) const {
        const int row0 = u.pm * 256 + wr * 64 + fr, col0 = u.pn * 256 + wc * 32 + 8 * fq;
#pragma unroll
        for (int ai = 0; ai < 2; ++ai)
#pragma unroll
            for (int m = 0; m < 4; ++m) {
                const int row = row0 + ai * 128 + m * 16;
#pragma unroll
                for (int bj = 0; bj < 2; ++bj) {
                    const size_t o = (size_t)row * DM + col0 + bj * 128;
                    const f32x4 x0 = __builtin_nontemporal_load((const f32x4*)(X + o)), x1 = __builtin_nontemporal_load((const f32x4*)(X + o + 4));
                    __builtin_nontemporal_store(x0 + acc[ai][bj][m][0], (f32x4*)(O + o)); __builtin_nontemporal_store(x1 + acc[ai][bj][m][1], (f32x4*)(O + o + 4));
                }
                __builtin_amdgcn_sched_barrier(0);
            }
    }
};

__device__ const double INVF[32] = {1.0, 0.7498942613601685, 0.5623413324356079, 0.4216965138912201, 0.3162277638912201, 0.23713737726211548, 0.17782793939113617, 0.133352130651474,
    0.10000000149011612, 0.07498941570520401, 0.05623413249850273, 0.04216965287923813, 0.03162277489900589, 0.023713737726211548, 0.017782794311642647, 0.01333521492779255,
    0.009999999776482582, 0.007498941849917173, 0.005623413249850273, 0.0042169648222625256, 0.003162277629598975, 0.00237137358635664, 0.0017782794311642647, 0.0013335214462131262,
    0.0010000000474974513, 0.0007498942431993783, 0.000562341301701963, 0.0004216965171508491, 0.0003162277571391314, 0.00023713737027719617, 0.00017782794020604342, 0.0001333521504420787};

__device__ __forceinline__ void transpose_item(const float* W, int ldw, int N, bf16_t* WT, int k0, int kd0, int n_src, int n_dst, LAS float* scr, int lane) {
    f32x4 wv[8];
#pragma unroll
    for (int i = 0; i < 8; ++i) wv[i] = __builtin_nontemporal_load((const f32x4*)(W + (size_t)(k0 + 8 * i + (lane >> 3)) * N + n_src + 4 * (lane & 7)));
#pragma unroll
    for (int i = 0; i < 8; ++i) { LAS float* d = scr + (8 * i + (lane >> 3)) * 33 + 4 * (lane & 7); d[0] = wv[i][0]; d[1] = wv[i][1]; d[2] = wv[i][2]; d[3] = wv[i][3]; }
    asm volatile("s_waitcnt lgkmcnt(0)" ::: "memory");
    const int c = lane & 7;
#pragma unroll
    for (int j = 0; j < 4; ++j) { const int n = (lane >> 3) + 8 * j; const LAS float* s = scr + (8 * c) * 33 + n;
        u32x4 o; o.x = pg8::cvt_pk_bf16(s[0 * 33], s[1 * 33]); o.y = pg8::cvt_pk_bf16(s[2 * 33], s[3 * 33]); o.z = pg8::cvt_pk_bf16(s[4 * 33], s[5 * 33]); o.w = pg8::cvt_pk_bf16(s[6 * 33], s[7 * 33]);
        *(u32x4*)(WT + (size_t)(n_dst + n) * ldw + kd0 + 8 * c) = o; }
    asm volatile("s_waitcnt lgkmcnt(0)" ::: "memory");
}

struct Ptrs {
    const float *x, *norm_g, *w_in, *conv_w, *conv_b, *qg, *kg, *wbc, *wba, *wout;
    float* out;
    bf16_t *WinT, *WcatT, *WoutT, *XN, *Mb, *PROJ, *Qb, *Kb, *Vb, *ZA;
    float *rope, *lse;
};

__device__ __forceinline__ void prologue(const Ptrs& F, LAS unsigned char* lds, int vcu, int G) {
    const int tid = threadIdx.x, lane = tid & 63, wave = tid >> 6;
    LAS float* scr = (LAS float*)(lds + wave * 16384);
    const int gw = vcu * NWAVES + wave, NGW = G * NWAVES;
    constexpr int NB_E = 36 * 8, I_E = 16 * NB_E;
    for (int it = gw; it < I_E; it += NGW) {
        const int nb = it % NB_E, kb = it / NB_E; const int nd = nb * 32;
        const int tile = nd >> 8, gidx = (nd & 255) >> 5, bj = gidx >> 2, wc = gidx & 3;
        const int ns = tile < 8 ? (bj ? 2048 : 1024) + 128 * tile + 32 * wc
                     : tile < 16 ? (bj ? 3072 : 0) + 128 * (tile - 8) + 32 * wc
                     : tile * 256 + wc * 64 + bj * 32;
        transpose_item(F.w_in, DM, NIN, F.WinT, kb * 64, kb * 64, ns, nd, scr, lane);
    }
    for (int m = gw; m < MTOT; m += 2 * NGW) {
        const int m2 = m + NGW;
        const bool has2 = m2 < MTOT;
        const f32x4* xr = (const f32x4*)(F.x + (size_t)m * DM) + lane;
        const f32x4* xr2 = (const f32x4*)(F.x + (size_t)(has2 ? m2 : m) * DM) + lane;
        const f32x4* gr = (const f32x4*)F.norm_g + lane;
        f32x4 v[4], w[4]; float s = 0.f, s2 = 0.f;
#pragma unroll
        for (int j = 0; j < 4; ++j) { v[j] = __builtin_nontemporal_load(xr + 64 * j); w[j] = __builtin_nontemporal_load(xr2 + 64 * j); }
#pragma unroll
        for (int j = 0; j < 4; ++j) { s += (v[j][0] * v[j][0] + v[j][1] * v[j][1]) + (v[j][2] * v[j][2] + v[j][3] * v[j][3]); s2 += (w[j][0] * w[j][0] + w[j][1] * w[j][1]) + (w[j][2] * w[j][2] + w[j][3] * w[j][3]); }
        const float rinv = rsqrtf(wave_sum(s) * (1.f / DM) + NORM_EPS), rinv2 = rsqrtf(wave_sum(s2) * (1.f / DM) + NORM_EPS);
        u32x2* o8 = (u32x2*)(F.XN + (size_t)m * DM) + lane;
        u32x2* o82 = (u32x2*)(F.XN + (size_t)m2 * DM) + lane;
#pragma unroll
        for (int j = 0; j < 4; ++j) { const f32x4 gg = gr[64 * j]; const f32x4 y = v[j] * rinv * gg, y2 = w[j] * rinv2 * gg;
            u32x2 p; p.x = pg8::cvt_pk_bf16(y[0], y[1]); p.y = pg8::cvt_pk_bf16(y[2], y[3]); o8[64 * j] = p;
            if (has2) { u32x2 q; q.x = pg8::cvt_pk_bf16(y2[0], y2[1]); q.y = pg8::cvt_pk_bf16(y2[2], y2[3]); o82[64 * j] = q; } }
    }
    for (int e = vcu * NTHREADS + tid; e < SEQ * 32; e += G * NTHREADS) {
        const int pos = e >> 5, i = e & 31;
        const double a = (double)(float)((float)pos * (float)INVF[i]);
        const double k = __builtin_rint(a * 0.15915494309189535);
        const double r = a - k * 6.283185307179586476925;
        const double r2 = r * r;
        double sn = 0.0, cs = 0.0;
#pragma unroll
        for (int n = 13; n >= 0; --n) {
            sn = 1.0 - sn * r2 * (1.0 / (double)((2 * n + 2) * (2 * n + 3)));
            cs = 1.0 - cs * r2 * (1.0 / (double)((2 * n + 1) * (2 * n + 2)));
        }
        F.rope[pos * 64 + i] = (float)cs; F.rope[pos * 64 + 32 + i] = (float)(sn * r);
    }
}

__device__ __forceinline__ void late_transposes(const Ptrs& F, LAS unsigned char* lds, int hw, int NHW) {
    const int tid = threadIdx.x, lane = tid & 63, wave = tid >> 6;
    LAS float* scr = (LAS float*)(lds + wave * 16384);
    constexpr int I_G = 16 * 64, I_BC = 16 * 32, I_BA = 8 * 32, I_OUT = 16 * 32, NL = I_G + I_BC + I_BA + I_OUT;
    for (int it = hw; it < NL; it += NHW) {
        int r = it;
        if (r < I_G) { const int nb = 36 * 8 + r % 64, kb = r / 64, nd = nb * 32; const int tile = nd >> 8, gidx = (nd & 255) >> 5, bj = gidx >> 2, wc = gidx & 3;
            transpose_item(F.w_in, DM, NIN, F.WinT, kb * 64, kb * 64, (bj ? 10240 : 9216) + 128 * (tile - 36) + 32 * wc, nd, scr, lane); continue; }
        r -= I_G;
        if (r < I_BC) { transpose_item(F.wbc, 1536, DM, F.WcatT, (r / 32) * 64, 512 + (r / 32) * 64, (r % 32) * 32, (r % 32) * 32, scr, lane); continue; }
        r -= I_BC;
        if (r < I_BA) { transpose_item(F.wba, 1536, DM, F.WcatT, (r / 32) * 64, (r / 32) * 64, (r % 32) * 32, (r % 32) * 32, scr, lane); continue; }
        r -= I_BA;
        transpose_item(F.wout, 1024, DM, F.WoutT, (r / 32) * 64, (r / 32) * 64, (r % 32) * 32, (r % 32) * 32, scr, lane);
    }
    __syncthreads();
}

__device__ __forceinline__ void attn_phase(LAS unsigned char* lds, const bf16_t* Qb, const bf16_t* Kb, const bf16_t* Vb, bf16_t* Ob, float* lse, int vcu, int G) {
    int tid_ = threadIdx.x; asm volatile("" : "+v"(tid_));
    const int tid = tid_, wid = __builtin_amdgcn_readfirstlane(tid >> 6), lane = tid & 63, fr = lane & 15, fq = lane >> 4;
    const int usel = wid >> 2, w4 = wid & 3;
    constexpr int NPAIR = (MP / SEQ) * NHEADS * 32;
    const int t0 = w4;
    const int dma_off = (lane >> 3) * 64 + (((lane & 7) ^ (((lane >> 4) & 3) << 1)) * 8);
    const int fk = ((fr >> 1) & 3) << 1;
    const int krow = 64 * usel + 16 * t0 + fr;
    const int koff0 = krow * 128 + ((fq ^ fk) * 16), koff1 = krow * 128 + (((fq + 4) ^ fk) * 16);
    const int fvh = (2 * fq + (fr >> 3)) & 3;
    const int vbase = 32768 + (64 * usel + 16 * t0 + 4 * fq + (fr >> 2)) * 128 + ((fr >> 1) & 1) * 16 + (fr & 1) * 8;
    const int qi = 16 * w4 + fr;
#define ATT_DECODE(IT, b_, hh_, dsh_, r_, n0_, L_) const int idx0_##IT = ((IT) & 31) * 2, bh_##IT = (IT) >> 5, hh_ = bh_##IT % NHEADS, b_ = bh_##IT / NHEADS, dsh_ = 2 * (hh_ >> 3), \
        r_ = idx0_##IT >> (6 - dsh_), n0_ = idx0_##IT & ((1 << (6 - dsh_)) - 1), L_ = SEQ >> dsh_
#define ATT_ISSUE(rowbase, buf) do { const bf16_t* kg_ = Kb + (long)(rowbase) * 64 + dma_off; const bf16_t* vg_ = Vb + (long)(rowbase) * 64 + dma_off; \
        _Pragma("unroll") for (int jj_ = 0; jj_ < 4; ++jj_) { const int j_ = wid + 8 * jj_; \
            __builtin_amdgcn_global_load_lds((const unsigned*)(kg_ + j_ * 512), (LAS unsigned*)(lds + (buf) * 65536 + j_ * 1024), 16, 0, 0); \
            __builtin_amdgcn_global_load_lds((const unsigned*)(vg_ + j_ * 512), (LAS unsigned*)(lds + (buf) * 65536 + 32768 + j_ * 1024), 16, 0, 0); } } while (0)
    f32x4 band[9];
#pragma unroll
    for (int t = 0; t < 9; ++t)
#pragma unroll
        for (int i = 0; i < 4; ++i) { const int rel = 16 * (t0 + t) + 4 * fq + i - qi; band[t][i] = (rel >= 0 && rel <= 128) ? 0.f : -INFINITY; }
    int it = vcu, buf = 0;
    bf16x8 Qn0 = (bf16x8){0, 0, 0, 0, 0, 0, 0, 0}, Qn1 = Qn0;
    if (it < NPAIR) {
        ATT_DECODE(it, b, hh, dsh, r, n0, L);
        const long rb = (long)(b * NHEADS + hh) * SEQ + r * L + 64 * n0;
        ATT_ISSUE(rb - 64, 0);
        const bf16_t* qrow = Qb + (rb + 64 * usel + qi) * 64;
        Qn0 = *(const bf16x8*)(qrow + 8 * fq); Qn1 = *(const bf16x8*)(qrow + 32 + 8 * fq);
    }
    for (; it < NPAIR; it += G) {
        ATT_DECODE(it, b, hh, dsh, r, n0, L);
        const long rb = (long)(b * NHEADS + hh) * SEQ + r * L + 64 * n0;
        const int n = n0 + usel;
        const bf16x8 Qf0 = Qn0, Qf1 = Qn1;
        asm volatile("s_waitcnt vmcnt(0)" ::: "memory");
        __syncthreads();
        const int itn = it + G;
        if (itn < NPAIR) {
            ATT_DECODE(itn, b2, hh2, dsh2, r2, n02, L2);
            const long rb2 = (long)(b2 * NHEADS + hh2) * SEQ + r2 * L2 + 64 * n02;
            ATT_ISSUE(rb2 - 64, buf ^ 1);
            const bf16_t* qrow2 = Qb + (rb2 + 64 * usel + qi) * 64;
            Qn0 = *(const bf16x8*)(qrow2 + 8 * fq); Qn1 = *(const bf16x8*)(qrow2 + 32 + 8 * fq);
        }
        const LAS unsigned char* kb = lds + buf * 65536;
        f32x4 S[9];
#pragma unroll
        for (int t = 0; t < 9; ++t) {
            const bf16x8 k0 = *(const LAS bf16x8*)(kb + koff0 + t * 2048), k1 = *(const LAS bf16x8*)(kb + koff1 + t * 2048);
            f32x4 sv = (f32x4){0.f, 0.f, 0.f, 0.f};
            sv = __builtin_amdgcn_mfma_f32_16x16x32_bf16(k0, Qf0, sv, 0, 0, 0);
            sv = __builtin_amdgcn_mfma_f32_16x16x32_bf16(k1, Qf1, sv, 0, 0, 0);
            S[t] = sv;
        }
        if (n == 0 || 64 * n + 128 > L) {
#pragma unroll
            for (int t = 0; t < 9; ++t)
#pragma unroll
                for (int i = 0; i < 4; ++i) { const int l = 64 * n - 64 + 16 * (t0 + t) + 4 * fq + i; if ((unsigned)l >= (unsigned)L) S[t][i] = -INFINITY; }
        }
        float mx = -INFINITY;
#pragma unroll
        for (int t = 0; t < 9; ++t) { S[t] += band[t]; mx = fmaxf(fmaxf(mx, fmaxf(S[t][0], S[t][1])), fmaxf(S[t][2], S[t][3])); }
        mx = fmaxf(mx, __shfl_xor(mx, 16)); mx = fmaxf(mx, __shfl_xor(mx, 32));
        float sum = 0.f;
#pragma unroll
        for (int t = 0; t < 9; ++t) {
            typedef float f32x2 __attribute__((ext_vector_type(2)));
            const f32x2 mm = (f32x2){mx, mx};
            f32x2 lo = (f32x2){S[t][0], S[t][1]}, hi = (f32x2){S[t][2], S[t][3]};
            asm("v_pk_add_f32 %0, %1, %2 neg_lo:[0,1] neg_hi:[0,1]" : "=v"(lo) : "v"(lo), "v"(mm));
            asm("v_pk_add_f32 %0, %1, %2 neg_lo:[0,1] neg_hi:[0,1]" : "=v"(hi) : "v"(hi), "v"(mm));
            const float p0 = fast_exp2(lo[0]), p1 = fast_exp2(lo[1]), p2 = fast_exp2(hi[0]), p3 = fast_exp2(hi[1]);
            S[t] = (f32x4){p0, p1, p2, p3}; sum += (p0 + p1) + (p2 + p3);
        }
        sum += __shfl_xor(sum, 16); sum += __shfl_xor(sum, 32);
        bf16x8 Pf[4];
#pragma unroll
        for (int pp = 0; pp < 4; ++pp) {
            u32x4 w; w.x = pg8::cvt_pk_bf16(S[2 * pp][0], S[2 * pp][1]); w.y = pg8::cvt_pk_bf16(S[2 * pp][2], S[2 * pp][3]);
            w.z = pg8::cvt_pk_bf16(S[2 * pp + 1][0], S[2 * pp + 1][1]); w.w = pg8::cvt_pk_bf16(S[2 * pp + 1][2], S[2 * pp + 1][3]);
            Pf[pp] = __builtin_bit_cast(bf16x8, w);
        }
        f32x4 O[4];
#pragma unroll
        for (int dt = 0; dt < 4; ++dt) O[dt] = (f32x4){0.f, 0.f, 0.f, 0.f};
        const LAS unsigned char* vb = kb + vbase;
        u32x2 w8; w8.x = pg8::cvt_pk_bf16(S[8][0], S[8][1]); w8.y = pg8::cvt_pk_bf16(S[8][2], S[8][3]);
        const s16x4 P8 = __builtin_bit_cast(s16x4, w8);
#pragma unroll
        for (int pp = 0; pp < 4; ++pp)
#pragma unroll
            for (int dt = 0; dt < 4; ++dt) {
                const LAS unsigned char* a1 = vb + (32 * pp) * 128 + 32 * (dt ^ fvh);
                const s16x4 lo = __builtin_amdgcn_ds_read_tr16_b64_v4i16((LAS s16x4*)a1);
                const s16x4 hi = __builtin_amdgcn_ds_read_tr16_b64_v4i16((LAS s16x4*)(a1 + 16 * 128));
                bf16x8 Vf; Vf[0] = lo[0]; Vf[1] = lo[1]; Vf[2] = lo[2]; Vf[3] = lo[3]; Vf[4] = hi[0]; Vf[5] = hi[1]; Vf[6] = hi[2]; Vf[7] = hi[3];
                O[dt] = __builtin_amdgcn_mfma_f32_16x16x32_bf16(Vf, Pf[pp], O[dt], 0, 0, 0);
            }
#pragma unroll
        for (int dt = 0; dt < 4; ++dt) {
            const s16x4 v8 = __builtin_amdgcn_ds_read_tr16_b64_v4i16((LAS s16x4*)(vb + 128 * 128 + 32 * (dt ^ fvh)));
            O[dt] = __builtin_amdgcn_mfma_f32_16x16x16bf16_1k(v8, P8, O[dt], 0, 0, 0);
        }
        const float inv = fast_rcp(sum);
        bf16_t* orow = Ob + (rb + 64 * usel + qi) * 64;
#pragma unroll
        for (int dt = 0; dt < 4; ++dt) {
            u32x2 w; w.x = pg8::cvt_pk_bf16(O[dt][0] * inv, O[dt][1] * inv); w.y = pg8::cvt_pk_bf16(O[dt][2] * inv, O[dt][3] * inv);
            *(u32x2*)(orow + 16 * dt + 4 * fq) = w;
        }
        if (fq == 0) lse[(size_t)(b * SEQ + ((64 * n + qi) << dsh) + r) * NHEADS + hh] = mx + __builtin_amdgcn_logf(sum);
        buf ^= 1;
    }
    __syncthreads();
#undef ATT_DECODE
#undef ATT_ISSUE
}

__device__ __forceinline__ void elem_phase(const Ptrs& F, bf16_t* P, const bf16_t* Ob, const bf16_t* ZA, const float* lse, int vcu, int G) {
    int tid_ = threadIdx.x; asm volatile("" : "+v"(tid_));
    const int tid = tid_, lane = tid & 63, wave = tid >> 6;
    f32x4 cw[2][4][2];
#pragma unroll
    for (int ii = 0; ii < 2; ++ii) { const int ch = 8 * (lane + 64 * ii);
#pragma unroll
        for (int t = 0; t < 3; ++t) { cw[ii][t][0] = *(const f32x4*)(F.conv_w + t * DM + ch); cw[ii][t][1] = *(const f32x4*)(F.conv_w + t * DM + ch + 4); }
        cw[ii][3][0] = *(const f32x4*)(F.conv_b + ch); cw[ii][3][1] = *(const f32x4*)(F.conv_b + ch + 4); }
    for (int rb = vcu; rb < MP / 16; rb += G) {
        const int row = rb * 16 + 2 * wave, s = row & (SEQ - 1);
        bf16_t* pr = P + (size_t)row * NP; const int bb = row >> 12;
#pragma unroll
        for (int ii = 0; ii < 2; ++ii) {
            const int ch = 8 * (lane + 64 * ii);
            float bz0[8], bz1[8], um[8], u0[8], u1[8], u2[8];
            const u32x4 z4 = (u32x4){0u, 0u, 0u, 0u};
            unpack8(__builtin_nontemporal_load((const u32x4*)(pr + OFF_BZ + ch)), bz0); unpack8(__builtin_nontemporal_load((const u32x4*)(pr + NP + OFF_BZ + ch)), bz1);
            unpack8(*(const u32x4*)(pr + OFF_U + ch), u0); unpack8(*(const u32x4*)(pr + NP + OFF_U + ch), u1);
            unpack8(s > 0 ? *(const u32x4*)(pr - NP + OFF_U + ch) : z4, um); unpack8(s + 1 < SEQ - 1 ? *(const u32x4*)(pr + 2 * NP + OFF_U + ch) : z4, u2);
            f32x4 y0[2], y1[2];
#pragma unroll
            for (int j = 0; j < 8; ++j) {
                const float w0 = cw[ii][0][j >> 2][j & 3], w1 = cw[ii][1][j >> 2][j & 3], w2 = cw[ii][2][j >> 2][j & 3], cb = cw[ii][3][j >> 2][j & 3];
                y0[j >> 2][j & 3] = bz0[j] * (um[j] * w0 + u0[j] * w1 + u1[j] * w2 + cb);
                y1[j >> 2][j & 3] = bz1[j] * (u0[j] * w0 + u1[j] * w1 + u2[j] * w2 + cb);
            }
            *(u32x4*)(pr + OFF_YC + ch) = pack8(y0[0], y0[1]);
            *(u32x4*)(pr + NP + OFF_YC + ch) = pack8(y1[0], y1[1]);
        }
        {
            const int h = lane >> 3, dc = (lane & 7) * 8;
#pragma unroll
            for (int rr = 0; rr < 2; ++rr) {
                const int sr = s + rr;
                const float* lp = lse + (size_t)(row + rr) * NHEADS + h;
                const float L0 = lp[0], L1 = lp[8], L2 = lp[16];
                const float mx = fmaxf(L0, fmaxf(L1, L2));
                float w0 = fast_exp2(L0 - mx), w1 = fast_exp2(L1 - mx), w2 = fast_exp2(L2 - mx);
                const float inv = fast_rcp(w0 + w1 + w2); w0 *= inv; w1 *= inv; w2 *= inv;
                float o0[8], o1[8], o2[8], za[8];
                const bf16_t* ob = Ob + ((size_t)(bb * NHEADS + h) * SEQ) * 64 + dc;
                unpack8(__builtin_nontemporal_load((const u32x4*)(ob + (size_t)sr * 64)), o0);
                unpack8(__builtin_nontemporal_load((const u32x4*)(ob + ((size_t)8 * SEQ + ((sr & 3) << 10) + (sr >> 2)) * 64)), o1);
                unpack8(__builtin_nontemporal_load((const u32x4*)(ob + ((size_t)16 * SEQ + ((sr & 15) << 8) + (sr >> 4)) * 64)), o2);
                unpack8(*(const u32x4*)(pr + rr * NP + OFF_ZA + h * 64 + dc), za);
                f32x4 y[2];
#pragma unroll
                for (int j = 0; j < 8; ++j) y[j >> 2][j & 3] = (w0 * o0[j] + w1 * o1[j] + w2 * o2[j]) * siluf_(za[j]);
                *(u32x4*)(pr + rr * NP + OFF_YA + h * 64 + dc) = pack8(y[0], y[1]);
            }
        }
    }
}

#define XB_TMO      128
#define XB_XCNT(j)  (256  + 64 * (j))
#define XB_XSUB(j)  (1280 + 64 * (j))
#define XB_XGEN(j)  (2304 + 64 * (j))
#define XB_TOP      3328
#define XB_TOPGEN   3392
#define XCD_BAR_WORDS 3456
#define XB_SPIN_CAP (1u << 18)

__device__ __forceinline__ unsigned xb_ld(unsigned* p)              { return __hip_atomic_load(p, __ATOMIC_RELAXED, __HIP_MEMORY_SCOPE_AGENT); }
__device__ __forceinline__ unsigned xb_add(unsigned* p, unsigned v) { return __hip_atomic_fetch_add(p, v, __ATOMIC_RELAXED, __HIP_MEMORY_SCOPE_AGENT); }
__device__ __forceinline__ unsigned xb_xcc_id() { return (unsigned)__builtin_amdgcn_s_getreg((3 << 11) | 20) & 0xFu; }
#define XB_SPIN(cond, bar) do { unsigned _sp = 0; while (cond) { __builtin_amdgcn_s_sleep(1); \
    if ((++_sp & 255u) == 0u) { if (xb_ld(&(bar)[XB_TMO])) break; if (_sp > XB_SPIN_CAP) { atomicAdd(&(bar)[XB_TMO], 1u); break; } } } } while (0)

struct XcdBarrier {
    unsigned* bar; unsigned x;
    volatile LAS unsigned* st;
};

__device__ __forceinline__ XcdBarrier xcd_barrier_post(unsigned* bar, volatile LAS unsigned* st) {
    XcdBarrier b; b.bar = bar; b.x = xb_xcc_id(); b.st = st;
    if (threadIdx.x == 0) (void)xb_add(&bar[XB_XCNT(b.x)], 1u);
    return b;
}
__device__ __forceinline__ void xcd_barrier_complete(unsigned* bar, unsigned x, unsigned& nloc, unsigned& nx) {
    const unsigned G = gridDim.x * gridDim.y * gridDim.z;
    unsigned sum, cnt, mine, sp = 0u;
    for (;;) {
        sum = 0u; cnt = 0u; mine = 0u;
#pragma unroll
        for (unsigned j = 0; j < 16; ++j) { const unsigned c = xb_ld(&bar[XB_XCNT(j)]); sum += c; cnt += (c > 0u) ? 1u : 0u; mine = (j == x) ? c : mine; }
        if (sum == G) break;
        __builtin_amdgcn_s_sleep(1);
        if ((++sp & 255u) == 0u) { if (xb_ld(&bar[XB_TMO])) break; if (sp > XB_SPIN_CAP) { atomicAdd(&bar[XB_TMO], 1u); break; } }
    }
    nloc = mine > 0u ? mine : 1u; nx = cnt > 0u ? cnt : 1u;
}

__device__ __forceinline__ void xcd_barrier(const XcdBarrier& b) {
    asm volatile("s_waitcnt vmcnt(0)" ::: "memory");
    __syncthreads();
    if (threadIdx.x == 0) {
        unsigned* bar = b.bar;
        __builtin_amdgcn_s_waitcnt(0);
        unsigned nloc = b.st[0], nx = b.st[1];
        if (nloc == 0u) { xcd_barrier_complete(bar, b.x, nloc, nx); b.st[0] = nloc; b.st[1] = nx; }
        const unsigned old = xb_add(&bar[XB_XSUB(b.x)], 1u);
        const unsigned gen = old / nloc;
        if (old + 1u == (gen + 1u) * nloc) {
            __builtin_amdgcn_fence(__ATOMIC_RELEASE, "agent");
            asm volatile("s_waitcnt vmcnt(0)" ::: "memory");
            const unsigned og = xb_add(&bar[XB_TOP], 1u);
            const unsigned tg = og / nx;
            if (og + 1u == (tg + 1u) * nx) xb_add(&bar[XB_TOPGEN], 1u);
            else XB_SPIN(xb_ld(&bar[XB_TOPGEN]) == tg, bar);
            __builtin_amdgcn_fence(__ATOMIC_ACQUIRE, "agent");
            xb_add(&bar[XB_XGEN(b.x)], 1u);
            asm volatile("s_waitcnt vmcnt(0)" ::: "memory");
        } else {
            XB_SPIN(xb_ld(&bar[XB_XGEN(b.x)]) == gen, bar);
            __builtin_amdgcn_fence(__ATOMIC_ACQUIRE, "agent");
            asm volatile("s_waitcnt vmcnt(0)" ::: "memory");
        }
    }
    __syncthreads();
}


struct Args { const float* in[10]; float* out; unsigned char* ws; int pad0, pad1; };

__global__ void __launch_bounds__(NTHREADS, 2) fwd_kernel(Args args) {
    extern __shared__ __attribute__((aligned(16))) unsigned char lds_raw[];
    LAS unsigned char* lds = (LAS unsigned char*)lds_raw;
    cg::grid_group grid = cg::this_grid();
    const int G = gridDim.x, bx = blockIdx.x;
    const int vcu = (G % 8 == 0) ? (bx % 8) * (G / 8) + bx / 8 : bx;
    unsigned char* ws = args.ws;
    Ptrs F;
    F.x = args.in[0]; F.norm_g = args.in[1]; F.w_in = args.in[2]; F.conv_w = args.in[3]; F.conv_b = args.in[4]; F.qg = args.in[5]; F.kg = args.in[6];
    F.wbc = args.in[7]; F.wba = args.in[8]; F.wout = args.in[9]; F.out = args.out;
    F.WinT = (bf16_t*)(ws + WS_WIN); F.WcatT = (bf16_t*)(ws + WS_WCAT); F.WoutT = (bf16_t*)(ws + WS_WOUT);
    F.XN = (bf16_t*)args.out;
    F.PROJ = (bf16_t*)(ws + WS_PROJ); F.Mb = F.PROJ + OFF_U; F.Qb = (bf16_t*)(ws + WS_Q); F.Kb = (bf16_t*)(ws + WS_K); F.Vb = (bf16_t*)(ws + WS_V); F.ZA = (bf16_t*)(ws + WS_ZA);
    F.rope = (float*)(ws + WS_ROPE); F.lse = (float*)(ws + WS_LSE);
    unsigned* barw = (unsigned*)(ws + WS_BAR);
    volatile LAS unsigned* st = (volatile LAS unsigned*)(lds + 131072);
    if (threadIdx.x < 64) st[threadIdx.x] = 0u;
    __syncthreads();
    XcdBarrier xbar = xcd_barrier_post(barw, st);
    if (args.pad0 != 0) grid.sync();

    prologue(F, lds, vcu, G);
    xcd_barrier(xbar);

    bf16_t* GC = (bf16_t*)(ws + WS_GC); bf16_t* GA = (bf16_t*)(ws + WS_GA);
    EpiProj EP{F.PROJ, F.Qb, F.ZA, GC, F.qg, F.kg, F.rope};
    if (((bx >> 3) & 1) != 0) late_transposes(F, lds, ((((bx >> 4) << 3) | (bx & 7)) * NWAVES) + (threadIdx.x >> 6), (G >> 1) * NWAVES);
    {
        pg8::Gemm g{F.XN, F.WinT, DM, DM, DM}; pg8::StaticOrder S; S.init(MP, 36 * 256, G, bx, 0);
        pg8::gemm_phase<EpiProj, pg8::StaticOrder>(lds, g, S, EP);
    }
    xcd_barrier(xbar);
    attn_phase(lds, F.Qb, F.Kb, F.Vb, F.Qb, F.lse, vcu, G);
    xcd_barrier(xbar);
    const bool elem_first = ((bx >> 3) & 1) != 0;
    if (elem_first) elem_phase(F, F.PROJ, F.Qb, F.ZA, F.lse, vcu, G);
    {
        pg8::Gemm g{F.XN, F.WinT, DM, DM, DM};
        pg8::StaticOrder S2; S2.init(MP, 8 * 256, G, bx, 36);
        pg8::gemm_phase<EpiProj, pg8::StaticOrder>(lds, g, S2, EP);
    }
    if (!elem_first) elem_phase(F, F.PROJ, F.Qb, F.ZA, F.lse, vcu, G);
    xcd_barrier(xbar);
    {
        pg8::Gemm g{F.PROJ, F.WcatT, NP, 1536, 1536}; pg8::StaticOrder S; S.init(MP, DM, G, bx);
        EpiMerge E{GC, GA, F.Mb};
        pg8::gemm_phase<EpiMerge, pg8::StaticOrder>(lds, g, S, E);
    }
    xcd_barrier(xbar);
    {
        pg8::Gemm g{F.Mb, F.WoutT, NP, DM, DM}; pg8::StaticOrder S; S.init(MP, DM, G, bx);
        EpiOut E{F.x, F.out};
        pg8::gemm_phase<EpiOut, pg8::StaticOrder>(lds, g, S, E);
    }
}

extern "C" void kernel_launch(void* const* d_in, const int* in_sizes, int n_in, void* d_out, int out_size, void* d_ws, size_t ws_size, hipStream_t stream) {
    static int grid = 0;
    if (grid == 0) {
        if (n_in != 10 || in_sizes[0] != MTOT * DM || out_size != MTOT * DM || ws_size < WS_END) {
            fprintf(stderr, "kernel_launch: unexpected shapes (n_in %d, in0 %d, out %d, ws %zu)\n", n_in, n_in > 0 ? in_sizes[0] : -1, out_size, ws_size); grid = -1; return; }
        int dev = 0, cus = 0, per_cu = 0;
        hipGetDevice(&dev);
        hipDeviceGetAttribute(&cus, hipDeviceAttributeMultiprocessorCount, dev);
        if (hipFuncSetAttribute((const void*)fwd_kernel, hipFuncAttributeMaxDynamicSharedMemorySize, LDS_BYTES) != hipSuccess) { fprintf(stderr, "kernel_launch: hipFuncSetAttribute failed\n"); grid = -1; return; }
        if (hipOccupancyMaxActiveBlocksPerMultiprocessor(&per_cu, (const void*)fwd_kernel, NTHREADS, LDS_BYTES) != hipSuccess || per_cu < 1) { fprintf(stderr, "kernel_launch: occupancy query failed (%d)\n", per_cu); per_cu = 1; }
        (void)hipGetLastError();
        grid = cus * per_cu;
    }
    if (grid < 0) return;
    if (hipMemsetAsync((char*)d_ws + WS_BAR, 0, XCD_BAR_WORDS * 4, stream) != hipSuccess) { fprintf(stderr, "kernel_launch: memset failed\n"); return; }
    Args a{};
    for (int i = 0; i < 10; ++i) a.in[i] = (const float*)d_in[i];
    a.out = (float*)d_out; a.ws = (unsigned char*)d_ws;
    void* kargs[] = {&a};
    hipError_t e = hipLaunchCooperativeKernel((const void*)fwd_kernel, dim3(grid), dim3(NTHREADS), kargs, LDS_BYTES, stream);
    if (e != hipSuccess) fprintf(stderr, "cooperative launch failed: %s (grid %d)\n", hipGetErrorString(e), grid);
}
```

```cpp
#include <hip/hip_runtime.h>
#include <hip/hip_cooperative_groups.h>
#include <cstdio>
#include <cstdint>
namespace cg = cooperative_groups;

#define LAS __attribute__((address_space(3)))
typedef unsigned short bf16_t;
typedef short bf16x8 __attribute__((ext_vector_type(8)));
typedef short s16x4 __attribute__((ext_vector_type(4)));
typedef float f32x4 __attribute__((ext_vector_type(4)));
typedef unsigned u32x4 __attribute__((ext_vector_type(4)));
typedef unsigned u32x2 __attribute__((ext_vector_type(2)));

constexpr int SEQ = 4096, DM = 1024, NBATCH = 8, MTOT = NBATCH * SEQ;
constexpr int MP = MTOT;
constexpr int NIN = 11264;
constexpr int NP = 2560;
constexpr int OFF_ZA = 0, OFF_BZ = 512, OFF_U = 1536;
constexpr int OFF_YA = OFF_ZA, OFF_YC = OFF_BZ;
constexpr int NHEADS = 24;
constexpr float NORM_EPS = 1e-6f;
constexpr float QSCALE = 0.125f * 1.4426950408889634f;

constexpr size_t MiB = 1u << 20;
constexpr size_t WS_WIN = 0;
constexpr size_t WS_WCAT = 22 * MiB;
constexpr size_t WS_WOUT = 25 * MiB;
constexpr size_t WS_ROPE = 27 * MiB;
constexpr size_t WS_LSE = 28 * MiB;
constexpr size_t WS_BAR = 31 * MiB;
constexpr size_t WS_Q = 32 * MiB;
constexpr size_t WS_K = 128 * MiB;
constexpr size_t WS_V = 224 * MiB;
constexpr size_t WS_GC = 128 * MiB;
constexpr size_t WS_GA = 192 * MiB;
constexpr size_t WS_PROJ = 320 * MiB;
constexpr size_t WS_ZA = 480 * MiB;
constexpr size_t WS_END = 480 * MiB;

static_assert(WS_V - WS_K == WS_K - WS_Q, "q/k/v spacing");
constexpr int NWAVES = 8, NTHREADS = 512;
constexpr int LDS_BYTES = 131072 + 1024;

namespace pg8 {
constexpr int BM = 256, BK = 64, HALF = 128, HTB = HALF * BK * 2, NXCD = 8, WGM = 8;
__host__ __device__ __forceinline__ int lds_byte(int r, int c) { const int st = (r >> 4) * 2 + (c >> 5), rr = r & 15, cc = c & 31, ob = rr * 64 + cc * 2; return st * 1024 + (ob ^ (((ob >> 9) & 1) << 5)); }
__host__ __device__ __forceinline__ void stage_rc(int b, int& R, int& C) { const int st = b / 1024, sb = b % 1024, swz = sb ^ (((sb >> 9) & 1) << 5); R = (st >> 1) * 16 + swz / 64; C = (st & 1) * 32 + (swz % 64) / 2; }
__host__ __device__ __forceinline__ int perm32(int rho) { const int n = rho >> 4, i = rho & 15; return 8 * (i >> 2) + 4 * n + (i & 3); }

struct Unit { int pm, pn; };
struct Gemm { const bf16_t* A; const bf16_t* Bt; int lda, ldb, K; };

struct StaticOrder {
    int nM, nN, nwg, G, c, pn0;
    __device__ void init(int M, int N, int G_, int c_, int pn0_ = 0) { nM = M / BM; nN = N / BM; nwg = nM * nN; G = G_; c = c_; pn0 = pn0_; }
    __device__ bool next(int i, Unit& u) const {
        const long L = (long)i * G + c; if (L >= nwg) return false;
        int wgid = (int)L; { const int q = nwg / NXCD, r = nwg % NXCD, xcd = wgid % NXCD, off = wgid / NXCD; wgid = (xcd < r ? xcd * (q + 1) : r * (q + 1) + (xcd - r) * q) + off; }
        const int nig = WGM * nN, gid = wgid / nig, fm = gid * WGM, gsz = (nM - fm) < WGM ? (nM - fm) : WGM;
        u.pm = fm + ((wgid % nig) % gsz); u.pn = pn0 + (wgid % nig) / gsz; return true;
    }
};

__device__ __forceinline__ unsigned cvt_pk_bf16(float lo, float hi) { unsigned r; asm volatile("v_cvt_pk_bf16_f32 %0, %1, %2" : "=v"(r) : "v"(lo), "v"(hi)); return r; }

template <class Epi, class Sched>
__device__ __forceinline__ void gemm_phase(LAS unsigned char* lds, const Gemm g, const Sched& S, const Epi& E) {
    int tid_ = threadIdx.x; asm volatile("" : "+v"(tid_));
    const int tid = tid_, wid = __builtin_amdgcn_readfirstlane(tid >> 6), lane = tid & 63, wr = wid >> 2, wc = wid & 3, fr = lane & 15, fq = lane >> 4;
    const int K = g.K, nt = K / BK;
    unsigned voffA[2], voffB[2];
#pragma unroll
    for (int i = 0; i < 2; ++i) { int R, C; stage_rc(tid * 16 + i * 8192, R, C); const int Rb = (R & ~31) + perm32(R & 31);
        voffA[i] = (unsigned)(R * g.lda + C) * 2u; voffB[i] = (unsigned)(Rb * g.ldb + C) * 2u; }
    const size_t kstep = (size_t)(BK * 2);
    const size_t hstepA = (size_t)HALF * g.lda * 2, hstepB = (size_t)HALF * g.ldb * 2;
    const size_t tstepA = 2 * hstepA, tstepB = 2 * hstepB;
    const unsigned ldsw = (unsigned)wid * 1024u;
    const int aoff = lds_byte(wr * 64 + fr, fq * 8), boff = lds_byte(wc * 32 + fr, fq * 8);
#define PG8_SA(b, h) (((b) * 2 + (h)) * HTB)
#define PG8_SB(b, h) ((4 + (b) * 2 + (h)) * HTB)
#define PG8_STAGE(bufoff, gbase, voff) do { _Pragma("unroll") for (int _i = 0; _i < 2; ++_i) \
        __builtin_amdgcn_global_load_lds((const unsigned*)((const char*)(gbase) + (voff)[_i]), (LAS unsigned*)(lds + (bufoff) + ldsw + _i * 8192), 16, 0, 0); } while (0)
#define PG8_LDA(dst, b, h) do { _Pragma("unroll") for (int m = 0; m < 4; ++m) _Pragma("unroll") for (int k = 0; k < 2; ++k) dst[m][k] = *(const LAS bf16x8*)(lds + PG8_SA(b, h) + aoff + m * 2048 + k * 1024); } while (0)
#define PG8_LDB(dst, b, h) do { _Pragma("unroll") for (int n = 0; n < 2; ++n) _Pragma("unroll") for (int k = 0; k < 2; ++k) dst[n][k] = *(const LAS bf16x8*)(lds + PG8_SB(b, h) + boff + n * 2048 + k * 1024); } while (0)
#define PG8_MMA(ai, bj, At, Bt) do { __builtin_amdgcn_s_setprio(1); _Pragma("unroll") for (int m = 0; m < 4; ++m) _Pragma("unroll") for (int n = 0; n < 2; ++n) _Pragma("unroll") for (int k = 0; k < 2; ++k) \
        acc[ai][bj][m][n] = __builtin_amdgcn_mfma_f32_16x16x32_bf16(Bt[n][k], At[m][k], acc[ai][bj][m][n], 0, 0, 0); __builtin_amdgcn_s_setprio(0); } while (0)
#define PG8_WAIT_V(n) asm volatile("s_waitcnt vmcnt(" #n ")" ::: "memory")
#define PG8_WAIT_L(n) asm volatile("s_waitcnt lgkmcnt(" #n ")" ::: "memory")
#define PG8_BAR __builtin_amdgcn_s_barrier()
#define PG8_SCHED __builtin_amdgcn_sched_barrier(0)
    Unit cur, nxt; int ui = 0;
    if (!S.next(0, cur)) return;
    f32x4 acc[2][2][4][2];
#pragma unroll
    for (int a = 0; a < 2; ++a)
#pragma unroll
        for (int b = 0; b < 2; ++b)
#pragma unroll
            for (int m = 0; m < 4; ++m)
#pragma unroll
                for (int n = 0; n < 2; ++n) acc[a][b][m][n] = (f32x4){0.f, 0.f, 0.f, 0.f};
    bf16x8 At[4][2], B0[2][2], B1[2][2];
    const char* cA = (const char*)g.A + (size_t)cur.pm * tstepA; const char* cB = (const char*)g.Bt + (size_t)cur.pn * tstepB;
    PG8_STAGE(PG8_SB(0, 0), cB, voffB); PG8_STAGE(PG8_SB(0, 1), cB + hstepB, voffB); PG8_STAGE(PG8_SA(0, 0), cA, voffA); PG8_STAGE(PG8_SA(0, 1), cA + hstepA, voffA);
    if (wr == 1) PG8_BAR;
    PG8_WAIT_V(2); PG8_BAR;
    PG8_STAGE(PG8_SB(1, 0), cB + kstep, voffB); PG8_STAGE(PG8_SA(1, 0), cA + kstep, voffA); PG8_STAGE(PG8_SB(1, 1), cB + hstepB + kstep, voffB);
    PG8_WAIT_V(6); PG8_BAR;
    for (;;) {
        const bool has_next = S.next(ui + 1, nxt);
        const char* nA = has_next ? (const char*)g.A + (size_t)nxt.pm * tstepA : cA; const char* nB = has_next ? (const char*)g.Bt + (size_t)nxt.pn * tstepB : cB;
        for (int t = 0; t < nt; t += 2) {
            const bool last = (t == nt - 2);
            const char* a1 = cA + (size_t)(t + 1) * kstep;
            const char* a2 = last ? nA : cA + (size_t)(t + 2) * kstep; const char* b2 = last ? nB : cB + (size_t)(t + 2) * kstep;
            const char* a3 = a2 + kstep; const char* b3 = b2 + kstep;
            if constexpr (Epi::MIDK > 0) { if (t == Epi::MIDK) E.mid(acc, cur, wr, wc, fr, fq); }
            PG8_LDB(B0, 0, 0); PG8_LDB(B1, 0, 1); PG8_SCHED; PG8_LDA(At, 0, 0); PG8_STAGE(PG8_SA(1, 1), a1 + hstepA, voffA);
            PG8_WAIT_V(8); PG8_WAIT_L(0); PG8_BAR; PG8_MMA(0, 0, At, B0); PG8_MMA(0, 1, At, B1); PG8_BAR; PG8_SCHED;
            PG8_LDA(At, 0, 1); PG8_STAGE(PG8_SB(0, 0), b2, voffB); PG8_STAGE(PG8_SB(0, 1), b2 + hstepB, voffB); PG8_STAGE(PG8_SA(0, 0), a2, voffA);
            PG8_WAIT_V(8); PG8_WAIT_L(0); PG8_BAR; PG8_MMA(1, 0, At, B0); PG8_MMA(1, 1, At, B1); PG8_BAR; PG8_SCHED;
            PG8_LDB(B0, 1, 0); PG8_LDB(B1, 1, 1); PG8_SCHED; PG8_LDA(At, 1, 0); PG8_STAGE(PG8_SA(0, 1), a2 + hstepA, voffA);
            PG8_WAIT_V(8); PG8_WAIT_L(0); PG8_BAR; PG8_MMA(0, 0, At, B0); PG8_MMA(0, 1, At, B1); PG8_BAR; PG8_SCHED;
            PG8_LDA(At, 1, 1); PG8_STAGE(PG8_SB(1, 0), b3, voffB); PG8_STAGE(PG8_SB(1, 1), b3 + hstepB, voffB); PG8_STAGE(PG8_SA(1, 0), a3, voffA);
            PG8_WAIT_V(8); PG8_WAIT_L(0); PG8_BAR; PG8_MMA(1, 0, At, B0); PG8_MMA(1, 1, At, B1); PG8_BAR; PG8_SCHED;
        }
        if (wr == 0) PG8_BAR;
        E(acc, cur, wr, wc, fr, fq);
        if (!has_next) break;
#pragma unroll
        for (int a = 0; a < 2; ++a)
#pragma unroll
            for (int b = 0; b < 2; ++b)
#pragma unroll
                for (int m = 0; m < 4; ++m)
#pragma unroll
                    for (int n = 0; n < 2; ++n) acc[a][b][m][n] = (f32x4){0.f, 0.f, 0.f, 0.f};
        cur = nxt; cA = nA; cB = nB; ++ui;
        if (wr == 1) PG8_BAR;
    }
    PG8_WAIT_V(0);
    PG8_BAR;
#undef PG8_SA
#undef PG8_SB
#undef PG8_STAGE
#undef PG8_LDA
#undef PG8_LDB
#undef PG8_MMA
#undef PG8_WAIT_V
#undef PG8_WAIT_L
#undef PG8_BAR
#undef PG8_SCHED
}
}

__device__ __forceinline__ float bf_lo(unsigned w) { return __uint_as_float(w << 16); }
__device__ __forceinline__ float bf_hi(unsigned w) { return __uint_as_float(w & 0xffff0000u); }
__device__ __forceinline__ float fast_rcp(float x) { return __builtin_amdgcn_rcpf(x); }
__device__ __forceinline__ float fast_exp2(float x) { return __builtin_amdgcn_exp2f(x); }
__device__ __forceinline__ float sigmoidf_(float x) { return fast_rcp(1.f + fast_exp2(-1.4426950408889634f * x)); }
__device__ __forceinline__ float siluf_(float x) { return x * sigmoidf_(x); }
__device__ __forceinline__ u32x4 pack8(const f32x4 a, const f32x4 b) {
    u32x4 w; w.x = pg8::cvt_pk_bf16(a[0], a[1]); w.y = pg8::cvt_pk_bf16(a[2], a[3]); w.z = pg8::cvt_pk_bf16(b[0], b[1]); w.w = pg8::cvt_pk_bf16(b[2], b[3]); return w;
}
__device__ __forceinline__ void unpack8(const u32x4 w, float (&f)[8]) {
    f[0] = bf_lo(w.x); f[1] = bf_hi(w.x); f[2] = bf_lo(w.y); f[3] = bf_hi(w.y); f[4] = bf_lo(w.z); f[5] = bf_hi(w.z); f[6] = bf_lo(w.w); f[7] = bf_hi(w.w);
}
__device__ __forceinline__ float wave_sum(float v) {
#pragma unroll
    for (int o = 1; o < 64; o <<= 1) v += __shfl_xor(v, o);
    return v;
}

struct EpiProj {
    static constexpr int MIDK = 0;
    bf16_t* P; bf16_t* Qb; bf16_t* ZA; bf16_t* GCp; const float* qg; const float* kg; const float* rope;
    __device__ __forceinline__ void operator()(const f32x4 (&acc)[2][2][4][2], const pg8::Unit& u, int wr, int wc, int fr, int fq) const {
        const int pn = u.pn;
        const int row0 = u.pm * 256 + wr * 64 + fr;
        if (pn >= 16 && pn < 34) {
            const int sel = pn < 22 ? 0 : (pn < 28 ? 1 : 2);
            const int hh = (pn - 16 - 6 * sel) * 4 + wc, dsh = 2 * (hh >> 3);
            bf16_t* base = Qb + (size_t)sel * ((WS_K - WS_Q) / 2) + (size_t)hh * (SEQ * 64) + 8 * fq;
            if (sel < 2) {
                const float* gp = sel == 0 ? qg : kg;
                const float sc = sel == 0 ? QSCALE : 1.f;
                const f32x4 g00 = *(const f32x4*)(gp + 8 * fq), g01 = *(const f32x4*)(gp + 8 * fq + 4), g10 = *(const f32x4*)(gp + 32 + 8 * fq), g11 = *(const f32x4*)(gp + 36 + 8 * fq);
#pragma unroll
                for (int ai = 0; ai < 2; ++ai)
#pragma unroll
                    for (int m = 0; m < 4; ++m) {
                        float ss = 0.f;
#pragma unroll
                        for (int bj = 0; bj < 2; ++bj)
#pragma unroll
                            for (int n = 0; n < 2; ++n) { const f32x4 x = acc[ai][bj][m][n]; ss += (x[0] * x[0] + x[1] * x[1]) + (x[2] * x[2] + x[3] * x[3]); }
                        ss += __shfl_xor(ss, 16); ss += __shfl_xor(ss, 32);
                        const float rinv = rsqrtf(ss * (1.f / 64.f) + NORM_EPS) * sc;
                        const int row = row0 + ai * 128 + m * 16, pos = row & (SEQ - 1), bb = row >> 12;
                        const int p = ((pos & ((1 << dsh) - 1)) << (12 - dsh)) + (pos >> dsh);
                        const float* rp = rope + pos * 64 + 8 * fq;
                        f32x4 o1[2], o2[2];
#pragma unroll
                        for (int n = 0; n < 2; ++n) {
                            const f32x4 c = *(const f32x4*)(rp + 4 * n), sn = *(const f32x4*)(rp + 32 + 4 * n);
                            const f32x4 t1 = acc[ai][0][m][n] * rinv * (n == 0 ? g00 : g01), t2 = acc[ai][1][m][n] * rinv * (n == 0 ? g10 : g11);
                            o1[n] = t1 * c - t2 * sn; o2[n] = t2 * c + t1 * sn;
                        }
                        bf16_t* dst = base + ((size_t)bb * (NHEADS * SEQ) + p) * 64;
                        __builtin_nontemporal_store(pack8(o1[0], o1[1]), (u32x4*)dst);
                        __builtin_nontemporal_store(pack8(o2[0], o2[1]), (u32x4*)(dst + 32));
                    }
            } else {
#pragma unroll
                for (int ai = 0; ai < 2; ++ai)
#pragma unroll
                    for (int m = 0; m < 4; ++m) {
                        const int row = row0 + ai * 128 + m * 16, pos = row & (SEQ - 1), bb = row >> 12;
                        const int p = ((pos & ((1 << dsh) - 1)) << (12 - dsh)) + (pos >> dsh);
                        bf16_t* dst = base + ((size_t)bb * (NHEADS * SEQ) + p) * 64;
                        __builtin_nontemporal_store(pack8(acc[ai][0][m][0], acc[ai][0][m][1]), (u32x4*)dst);
                        __builtin_nontemporal_store(pack8(acc[ai][1][m][0], acc[ai][1][m][1]), (u32x4*)(dst + 32));
                    }
            }
        } else {
            if (pn < 16) {
                const bool isu = pn < 8;
                const int cb = (isu ? OFF_U : OFF_BZ) + 128 * (pn & 7) + 32 * wc + 8 * fq;
#pragma unroll
                for (int ai = 0; ai < 2; ++ai)
#pragma unroll
                    for (int m = 0; m < 4; ++m) {
                        f32x4 v0 = acc[ai][0][m][0], v1 = acc[ai][0][m][1];
                        const f32x4 y0 = acc[ai][1][m][0], y1 = acc[ai][1][m][1];
                        if (isu) { v0 *= y0; v1 *= y1; }
                        else {
#pragma unroll
                            for (int j = 0; j < 4; ++j) { v0[j] *= siluf_(y0[j]); v1[j] *= siluf_(y1[j]); }
                        }
                        __builtin_nontemporal_store(pack8(v0, v1), (u32x4*)(P + (size_t)(row0 + ai * 128 + m * 16) * NP + cb));
                    }
            } else {
                if (pn >= 36) {
                    const int gcol = 128 * (pn - 36) + 32 * wc + 8 * fq;
#pragma unroll
                    for (int ai = 0; ai < 2; ++ai)
#pragma unroll
                        for (int m = 0; m < 4; ++m) {
                            const size_t go = (size_t)(row0 + ai * 128 + m * 16) * 1024 + gcol;
                            f32x4 sc[2], rho[2];
#pragma unroll
                            for (int n = 0; n < 2; ++n)
#pragma unroll
                                for (int j = 0; j < 4; ++j) {
                                    const float ec = fminf(fast_exp2(-1.4426950408889634f * acc[ai][0][m][n][j]), 1e30f), ea = fast_exp2(-1.4426950408889634f * acc[ai][1][m][n][j]);
                                    sc[n][j] = fast_rcp(1.f + ec); rho[n][j] = (1.f + ec) * fast_rcp(1.f + ea);
                                }
                            *(u32x4*)(GCp + go) = pack8(sc[0], sc[1]);
                            *(u32x4*)(GCp + (WS_GA - WS_GC) / 2 + go) = pack8(rho[0], rho[1]);
                        }
                    return;
                }
                bf16_t* base = P + OFF_ZA + (pn - 34) * 256 + wc * 64 + 8 * fq;
#pragma unroll
                for (int ai = 0; ai < 2; ++ai)
#pragma unroll
                    for (int m = 0; m < 4; ++m) {
                        bf16_t* dst = base + (size_t)(row0 + ai * 128 + m * 16) * NP;
                        __builtin_nontemporal_store(pack8(acc[ai][0][m][0], acc[ai][0][m][1]), (u32x4*)dst);
                        __builtin_nontemporal_store(pack8(acc[ai][1][m][0], acc[ai][1][m][1]), (u32x4*)(dst + 32));
                    }
            }
        }
    }
};

struct EpiGate {
    static constexpr int MIDK = 0;
    bf16_t* Gx;
    __device__ __forceinline__ void operator()(const f32x4 (&acc)[2][2][4][2], const pg8::Unit& u, int wr, int wc, int fr, int fq) const {
        const int row0 = u.pm * 256 + wr * 64 + fr, col0 = u.pn * 256 + wc * 32 + 8 * fq;
#pragma unroll
        for (int ai = 0; ai < 2; ++ai)
#pragma unroll
            for (int m = 0; m < 4; ++m) {
                bf16_t* dst = Gx + (size_t)(row0 + ai * 128 + m * 16) * 1024 + col0;
#pragma unroll
                for (int bj = 0; bj < 2; ++bj) {
                    f32x4 v0 = acc[ai][bj][m][0], v1 = acc[ai][bj][m][1];
#pragma unroll
                    for (int j = 0; j < 4; ++j) { v0[j] = sigmoidf_(v0[j]); v1[j] = sigmoidf_(v1[j]); }
                    *(u32x4*)(dst + bj * 128) = pack8(v0, v1);
                }
            }
    }
};

struct EpiMerge {
    static constexpr int MIDK = 8;
    const bf16_t* GC; const bf16_t* GA; bf16_t* Mb;
    __device__ __forceinline__ void mid(f32x4 (&acc)[2][2][4][2], const pg8::Unit& u, int wr, int wc, int fr_, int fq_) const {
        int fr = fr_, fq = fq_; asm volatile("" : "+v"(fr), "+v"(fq));
        const int row0 = u.pm * 256 + wr * 64 + fr, col0 = u.pn * 256 + wc * 32 + 8 * fq;
#pragma unroll
        for (int ai = 0; ai < 2; ++ai)
#pragma unroll
            for (int m = 0; m < 4; ++m) {
                const size_t go = (size_t)(row0 + ai * 128 + m * 16) * 1024 + col0;
#pragma unroll
                for (int bj = 0; bj < 2; ++bj) {
                    float rh[8]; unpack8(__builtin_nontemporal_load((const u32x4*)(GA + go + bj * 128)), rh);
#pragma unroll
                    for (int j = 0; j < 4; ++j) { acc[ai][bj][m][0][j] *= rh[j]; acc[ai][bj][m][1][j] *= rh[4 + j]; }
                }
                __builtin_amdgcn_sched_barrier(0);
            }
    }
    __device__ __forceinline__ void operator()(const f32x4 (&acc)[2][2][4][2], const pg8::Unit& u, int wr, int wc, int fr, int fq) const {
        const int row0 = u.pm * 256 + wr * 64 + fr, col0 = u.pn * 256 + wc * 32 + 8 * fq;
#pragma unroll
        for (int ai = 0; ai < 2; ++ai) {
            u32x4 g[4][2];
#pragma unroll
            for (int m = 0; m < 4; ++m)
#pragma unroll
                for (int bj = 0; bj < 2; ++bj) g[m][bj] = *(const u32x4*)(GC + (size_t)(row0 + ai * 128 + m * 16) * 1024 + col0 + bj * 128);
            __builtin_amdgcn_sched_barrier(0);
#pragma unroll
            for (int m = 0; m < 4; ++m) {
                const int row = row0 + ai * 128 + m * 16;
#pragma unroll
                for (int bj = 0; bj < 2; ++bj) {
                    const int col = col0 + bj * 128;
                    float gc[8]; unpack8(g[m][bj], gc);
                    f32x4 v0 = acc[ai][bj][m][0], v1 = acc[ai][bj][m][1];
#pragma unroll
                    for (int j = 0; j < 4; ++j) { v0[j] *= gc[j]; v1[j] *= gc[4 + j]; }
                    *(u32x4*)(Mb + (size_t)row * NP + col) = pack8(v0, v1);
                }
            }
            __builtin_amdgcn_sched_barrier(0);
        }
    }
};

struct EpiOut {
    static constexpr int MIDK = 0;
    const float* X; float* O;
    __device__ __forceinline__ void operator()(const f32x4 (&acc)[2][2][4][2], const pg8::Unit& u, int wr, int wc, int fr, int fq) const {
        const int row0 = u.pm * 256 + wr * 64 + fr, col0 = u.pn * 256 + wc * 32 + 8 * fq;
#pragma unroll
        for (int ai = 0; ai < 2; ++ai)
#pragma unroll
            for (int m = 0; m < 4; ++m) {
                const int row = row0 + ai * 128 + m * 16;
#pragma unroll
                for (int bj = 0; bj < 2; ++bj) {
                    const size_t o = (size_t)row * DM + col0 + bj * 128;
                    const f32x4 x0 = __builtin_nontemporal_load((const f32x4*)(X + o)), x1 = __builtin_nontemporal_load((const f32x4*)(X + o + 4));
                    __builtin_nontemporal_store(x0 + acc[ai][bj][m][0], (f32x4*)(O + o)); __builtin_nontemporal_store(x1 + acc[ai][bj][m][1], (f32x4*)(O + o + 4));
                }
                __builtin_amdgcn_sched_barrier(0);
            }
    }
};

__device__ const double INVF[32] = {1.0, 0.7498942613601685, 0.5623413324356079, 0.4216965138912201, 0.3162277638912201, 0.23713737726211548, 0.17782793939113617, 0.133352130651474,
    0.10000000149011612, 0.07498941570520401, 0.05623413249850273, 0.04216965287923813, 0.03162277489900589, 0.023713737726211548, 0.017782794311642647, 0.01333521492779255,
    0.009999999776482582, 0.007498941849917173, 0.005623413249850273, 0.0042169648222625256, 0.003162277629598975, 0.00237137358635664, 0.0017782794311642647, 0.0013335214462131262,
    0.0010000000474974513, 0.0007498942431993783, 0.000562341301701963, 0.0004216965171508491, 0.0003162277571391314, 0.00023713737027719617, 0.00017782794020604342, 0.0001333521504420787};

__device__ __forceinline__ void transpose_item(const float* W, int ldw, int N, bf16_t* WT, int k0, int kd0, int n_src, int n_dst, LAS float* scr, int lane) {
    f32x4 wv[8];
#pragma unroll
    for (int i = 0; i < 8; ++i) wv[i] = __builtin_nontemporal_load((const f32x4*)(W + (size_t)(k0 + 8 * i + (lane >> 3)) * N + n_src + 4 * (lane & 7)));
#pragma unroll
    for (int i = 0; i < 8; ++i) { LAS float* d = scr + (8 * i + (lane >> 3)) * 33 + 4 * (lane & 7); d[0] = wv[i][0]; d[1] = wv[i][1]; d[2] = wv[i][2]; d[3] = wv[i][3]; }
    asm volatile("s_waitcnt lgkmcnt(0)" ::: "memory");
    const int c = lane & 7;
#pragma unroll
    for (int j = 0; j < 4; ++j) { const int n = (lane >> 3) + 8 * j; const LAS float* s = scr + (8 * c) * 33 + n;
        u32x4 o; o.x = pg8::cvt_pk_bf16(s[0 * 33], s[1 * 33]); o.y = pg8::cvt_pk_bf16(s[2 * 33], s[3 * 33]); o.z = pg8::cvt_pk_bf16(s[4 * 33], s[5 * 33]); o.w = pg8::cvt_pk_bf16(s[6 * 33], s[7 * 33]);
        *(u32x4*)(WT + (size_t)(n_dst + n) * ldw + kd0 + 8 * c) = o; }
    asm volatile("s_waitcnt lgkmcnt(0)" ::: "memory");
}

struct Ptrs {
    const float *x, *norm_g, *w_in, *conv_w, *conv_b, *qg, *kg, *wbc, *wba, *wout;
    float* out;
    bf16_t *WinT, *WcatT, *WoutT, *XN, *Mb, *PROJ, *Qb, *Kb, *Vb, *ZA;
    float *rope, *lse;
};

__device__ __forceinline__ void prologue(const Ptrs& F, LAS unsigned char* lds, int vcu, int G) {
    const int tid = threadIdx.x, lane = tid & 63, wave = tid >> 6;
    LAS float* scr = (LAS float*)(lds + wave * 16384);
    const int gw = vcu * NWAVES + wave, NGW = G * NWAVES;
    constexpr int NB_E = 36 * 8, I_E = 16 * NB_E;
    for (int it = gw; it < I_E; it += NGW) {
        const int nb = it % NB_E, kb = it / NB_E; const int nd = nb * 32;
        const int tile = nd >> 8, gidx = (nd & 255) >> 5, bj = gidx >> 2, wc = gidx & 3;
        const int ns = tile < 8 ? (bj ? 2048 : 1024) + 128 * tile + 32 * wc
                     : tile < 16 ? (bj ? 3072 : 0) + 128 * (tile - 8) + 32 * wc
                     : tile * 256 + wc * 64 + bj * 32;
        transpose_item(F.w_in, DM, NIN, F.WinT, kb * 64, kb * 64, ns, nd, scr, lane);
    }
    for (int m = gw; m < MTOT; m += 2 * NGW) {
        const int m2 = m + NGW;
        const bool has2 = m2 < MTOT;
        const f32x4* xr = (const f32x4*)(F.x + (size_t)m * DM) + lane;
        const f32x4* xr2 = (const f32x4*)(F.x + (size_t)(has2 ? m2 : m) * DM) + lane;
        const f32x4* gr = (const f32x4*)F.norm_g + lane;
        f32x4 v[4], w[4]; float s = 0.f, s2 = 0.f;
#pragma unroll
        for (int j = 0; j < 4; ++j) { v[j] = __builtin_nontemporal_load(xr + 64 * j); w[j] = __builtin_nontemporal_load(xr2 + 64 * j); }
#pragma unroll
        for (int j = 0; j < 4; ++j) { s += (v[j][0] * v[j][0] + v[j][1] * v[j][1]) + (v[j][2] * v[j][2] + v[j][3] * v[j][3]); s2 += (w[j][0] * w[j][0] + w[j][1] * w[j][1]) + (w[j][2] * w[j][2] + w[j][3] * w[j][3]); }
        const float rinv = rsqrtf(wave_sum(s) * (1.f / DM) + NORM_EPS), rinv2 = rsqrtf(wave_sum(s2) * (1.f / DM) + NORM_EPS);
        u32x2* o8 = (u32x2*)(F.XN + (size_t)m * DM) + lane;
        u32x2* o82 = (u32x2*)(F.XN + (size_t)m2 * DM) + lane;
#pragma unroll
        for (int j = 0; j < 4; ++j) { const f32x4 gg = gr[64 * j]; const f32x4 y = v[j] * rinv * gg, y2 = w[j] * rinv2 * gg;
            u32x2 p; p.x = pg8::cvt_pk_bf16(y[0], y[1]); p.y = pg8::cvt_pk_bf16(y[2], y[3]); o8[64 * j] = p;
            if (has2) { u32x2 q; q.x = pg8::cvt_pk_bf16(y2[0], y2[1]); q.y = pg8::cvt_pk_bf16(y2[2], y2[3]); o82[64 * j] = q; } }
    }
    for (int e = vcu * NTHREADS + tid; e < SEQ * 32; e += G * NTHREADS) {
        const int pos = e >> 5, i = e & 31;
        const double a = (double)(float)((float)pos * (float)INVF[i]);
        const double k = __builtin_rint(a * 0.15915494309189535);
        const double r = a - k * 6.283185307179586476925;
        const double r2 = r * r;
        double sn = 0.0, cs = 0.0;
#pragma unroll
        for (int n = 13; n >= 0; --n) {
            sn = 1.0 - sn * r2 * (1.0 / (double)((2 * n + 2) * (2 * n + 3)));
            cs = 1.0 - cs * r2 * (1.0 / (double)((2 * n + 1) * (2 * n + 2)));
        }
        F.rope[pos * 64 + i] = (float)cs; F.rope[pos * 64 + 32 + i] = (float)(sn * r);
    }
}

__device__ __forceinline__ void late_transposes(const Ptrs& F, LAS unsigned char* lds, int hw, int NHW) {
    const int tid = threadIdx.x, lane = tid & 63, wave = tid >> 6;
    LAS float* scr = (LAS float*)(lds + wave * 16384);
    constexpr int I_G = 16 * 64, I_BC = 16 * 32, I_BA = 8 * 32, I_OUT = 16 * 32, NL = I_G + I_BC + I_BA + I_OUT;
    for (int it = hw; it < NL; it += NHW) {
        int r = it;
        if (r < I_G) { const int nb = 36 * 8 + r % 64, kb = r / 64, nd = nb * 32; const int tile = nd >> 8, gidx = (nd & 255) >> 5, bj = gidx >> 2, wc = gidx & 3;
            transpose_item(F.w_in, DM, NIN, F.WinT, kb * 64, kb * 64, (bj ? 10240 : 9216) + 128 * (tile - 36) + 32 * wc, nd, scr, lane); continue; }
        r -= I_G;
        if (r < I_BC) { transpose_item(F.wbc, 1536, DM, F.WcatT, (r / 32) * 64, 512 + (r / 32) * 64, (r % 32) * 32, (r % 32) * 32, scr, lane); continue; }
        r -= I_BC;
        if (r < I_BA) { transpose_item(F.wba, 1536, DM, F.WcatT, (r / 32) * 64, (r / 32) * 64, (r % 32) * 32, (r % 32) * 32, scr, lane); continue; }
        r -= I_BA;
        transpose_item(F.wout, 1024, DM, F.WoutT, (r / 32) * 64, (r / 32) * 64, (r % 32) * 32, (r % 32) * 32, scr, lane);
    }
    __syncthreads();
}

__device__ __forceinline__ void attn_phase(LAS unsigned char* lds, const bf16_t* Qb, const bf16_t* Kb, const bf16_t* Vb, bf16_t* Ob, float* lse, int vcu, int G) {
    int tid_ = threadIdx.x; asm volatile("" : "+v"(tid_));
    const int tid = tid_, wid = __builtin_amdgcn_readfirstlane(tid >> 6), lane = tid & 63, fr = lane & 15, fq = lane >> 4;
    const int usel = wid >> 2, w4 = wid & 3;
    constexpr int NPAIR = (MP / SEQ) * NHEADS * 32;
    const int t0 = w4;
    const int dma_off = (lane >> 3) * 64 + (((lane & 7) ^ (((lane >> 4) & 3) << 1)) * 8);
    const int fk = ((fr >> 1) & 3) << 1;
    const int krow = 64 * usel + 16 * t0 + fr;
    const int koff0 = krow * 128 + ((fq ^ fk) * 16), koff1 = krow * 128 + (((fq + 4) ^ fk) * 16);
    const int fvh = (2 * fq + (fr >> 3)) & 3;
    const int vbase = 32768 + (64 * usel + 16 * t0 + 4 * fq + (fr >> 2)) * 128 + ((fr >> 1) & 1) * 16 + (fr & 1) * 8;
    const int qi = 16 * w4 + fr;
#define ATT_DECODE(IT, b_, hh_, dsh_, r_, n0_, L_) const int idx0_##IT = ((IT) & 31) * 2, bh_##IT = (IT) >> 5, hh_ = bh_##IT % NHEADS, b_ = bh_##IT / NHEADS, dsh_ = 2 * (hh_ >> 3), \
        r_ = idx0_##IT >> (6 - dsh_), n0_ = idx0_##IT & ((1 << (6 - dsh_)) - 1), L_ = SEQ >> dsh_
#define ATT_ISSUE(rowbase, buf) do { const bf16_t* kg_ = Kb + (long)(rowbase) * 64 + dma_off; const bf16_t* vg_ = Vb + (long)(rowbase) * 64 + dma_off; \
        _Pragma("unroll") for (int jj_ = 0; jj_ < 4; ++jj_) { const int j_ = wid + 8 * jj_; \
            __builtin_amdgcn_global_load_lds((const unsigned*)(kg_ + j_ * 512), (LAS unsigned*)(lds + (buf) * 65536 + j_ * 1024), 16, 0, 0); \
            __builtin_amdgcn_global_load_lds((const unsigned*)(vg_ + j_ * 512), (LAS unsigned*)(lds + (buf) * 65536 + 32768 + j_ * 1024), 16, 0, 0); } } while (0)
    f32x4 band0, band8;
#pragma unroll
    for (int i = 0; i < 4; ++i) { const int r0 = 4 * fq + i - fr, r8 = 128 + 4 * fq + i - fr; band0[i] = r0 >= 0 ? 0.f : -INFINITY; band8[i] = r8 <= 128 ? 0.f : -INFINITY; }
    int it = vcu, buf = 0;
    bf16x8 Qn0 = (bf16x8){0, 0, 0, 0, 0, 0, 0, 0}, Qn1 = Qn0;
    if (it < NPAIR) {
        ATT_DECODE(it, b, hh, dsh, r, n0, L);
        const long rb = (long)(b * NHEADS + hh) * SEQ + r * L + 64 * n0;
        ATT_ISSUE(rb - 64, 0);
        const bf16_t* qrow = Qb + (rb + 64 * usel + qi) * 64;
        Qn0 = *(const bf16x8*)(qrow + 8 * fq); Qn1 = *(const bf16x8*)(qrow + 32 + 8 * fq);
    }
    for (; it < NPAIR; it += G) {
        ATT_DECODE(it, b, hh, dsh, r, n0, L);
        const long rb = (long)(b * NHEADS + hh) * SEQ + r * L + 64 * n0;
        const int n = n0 + usel;
        const bf16x8 Qf0 = Qn0, Qf1 = Qn1;
        asm volatile("s_waitcnt vmcnt(0)" ::: "memory");
        __syncthreads();
        const int itn = it + G;
        if (itn < NPAIR) {
            ATT_DECODE(itn, b2, hh2, dsh2, r2, n02, L2);
            const long rb2 = (long)(b2 * NHEADS + hh2) * SEQ + r2 * L2 + 64 * n02;
            ATT_ISSUE(rb2 - 64, buf ^ 1);
            const bf16_t* qrow2 = Qb + (rb2 + 64 * usel + qi) * 64;
            Qn0 = *(const bf16x8*)(qrow2 + 8 * fq); Qn1 = *(const bf16x8*)(qrow2 + 32 + 8 * fq);
        }
        const LAS unsigned char* kb = lds + buf * 65536;
        f32x4 S[9];
#pragma unroll
        for (int t = 0; t < 9; ++t) {
            const bf16x8 k0 = *(const LAS bf16x8*)(kb + koff0 + t * 2048), k1 = *(const LAS bf16x8*)(kb + koff1 + t * 2048);
            f32x4 sv = (f32x4){0.f, 0.f, 0.f, 0.f};
            sv = __builtin_amdgcn_mfma_f32_16x16x32_bf16(k0, Qf0, sv, 0, 0, 0);
            sv = __builtin_amdgcn_mfma_f32_16x16x32_bf16(k1, Qf1, sv, 0, 0, 0);
            S[t] = sv;
        }
        if (n == 0 || 64 * n + 128 > L) {
#pragma unroll
            for (int t = 0; t < 9; ++t)
#pragma unroll
                for (int i = 0; i < 4; ++i) { const int l = 64 * n - 64 + 16 * (t0 + t) + 4 * fq + i; if ((unsigned)l >= (unsigned)L) S[t][i] = -INFINITY; }
        }
        float mx = -INFINITY;
        S[0] += band0; S[8] += band8;
#pragma unroll
        for (int t = 0; t < 9; ++t) mx = fmaxf(fmaxf(mx, fmaxf(S[t][0], S[t][1])), fmaxf(S[t][2], S[t][3]));
        mx = fmaxf(mx, __shfl_xor(mx, 16)); mx = fmaxf(mx, __shfl_xor(mx, 32));
        float sum = 0.f;
#pragma unroll
        for (int t = 0; t < 9; ++t) {
            typedef float f32x2 __attribute__((ext_vector_type(2)));
            const f32x2 mm = (f32x2){mx, mx};
            f32x2 lo = (f32x2){S[t][0], S[t][1]}, hi = (f32x2){S[t][2], S[t][3]};
            asm("v_pk_add_f32 %0, %1, %2 neg_lo:[0,1] neg_hi:[0,1]" : "=v"(lo) : "v"(lo), "v"(mm));
            asm("v_pk_add_f32 %0, %1, %2 neg_lo:[0,1] neg_hi:[0,1]" : "=v"(hi) : "v"(hi), "v"(mm));
            const float p0 = fast_exp2(lo[0]), p1 = fast_exp2(lo[1]), p2 = fast_exp2(hi[0]), p3 = fast_exp2(hi[1]);
            S[t] = (f32x4){p0, p1, p2, p3}; sum += (p0 + p1) + (p2 + p3);
        }
        sum += __shfl_xor(sum, 16); sum += __shfl_xor(sum, 32);
        bf16x8 Pf[4];
#pragma unroll
        for (int pp = 0; pp < 4; ++pp) {
            u32x4 w; w.x = pg8::cvt_pk_bf16(S[2 * pp][0], S[2 * pp][1]); w.y = pg8::cvt_pk_bf16(S[2 * pp][2], S[2 * pp][3]);
            w.z = pg8::cvt_pk_bf16(S[2 * pp + 1][0], S[2 * pp + 1][1]); w.w = pg8::cvt_pk_bf16(S[2 * pp + 1][2], S[2 * pp + 1][3]);
            Pf[pp] = __builtin_bit_cast(bf16x8, w);
        }
        f32x4 O[4];
#pragma unroll
        for (int dt = 0; dt < 4; ++dt) O[dt] = (f32x4){0.f, 0.f, 0.f, 0.f};
        const LAS unsigned char* vb = kb + vbase;
        u32x2 w8; w8.x = pg8::cvt_pk_bf16(S[8][0], S[8][1]); w8.y = pg8::cvt_pk_bf16(S[8][2], S[8][3]);
        const s16x4 P8 = __builtin_bit_cast(s16x4, w8);
#pragma unroll
        for (int pp = 0; pp < 4; ++pp)
#pragma unroll
            for (int dt = 0; dt < 4; ++dt) {
                const LAS unsigned char* a1 = vb + (32 * pp) * 128 + 32 * (dt ^ fvh);
                const s16x4 lo = __builtin_amdgcn_ds_read_tr16_b64_v4i16((LAS s16x4*)a1);
                const s16x4 hi = __builtin_amdgcn_ds_read_tr16_b64_v4i16((LAS s16x4*)(a1 + 16 * 128));
                bf16x8 Vf; Vf[0] = lo[0]; Vf[1] = lo[1]; Vf[2] = lo[2]; Vf[3] = lo[3]; Vf[4] = hi[0]; Vf[5] = hi[1]; Vf[6] = hi[2]; Vf[7] = hi[3];
                O[dt] = __builtin_amdgcn_mfma_f32_16x16x32_bf16(Vf, Pf[pp], O[dt], 0, 0, 0);
            }
#pragma unroll
        for (int dt = 0; dt < 4; ++dt) {
            const s16x4 v8 = __builtin_amdgcn_ds_read_tr16_b64_v4i16((LAS s16x4*)(vb + 128 * 128 + 32 * (dt ^ fvh)));
            O[dt] = __builtin_amdgcn_mfma_f32_16x16x16bf16_1k(v8, P8, O[dt], 0, 0, 0);
        }
        const float inv = fast_rcp(sum);
        bf16_t* orow = Ob + (rb + 64 * usel + qi) * 64;
#pragma unroll
        for (int dt = 0; dt < 4; ++dt) {
            u32x2 w; w.x = pg8::cvt_pk_bf16(O[dt][0] * inv, O[dt][1] * inv); w.y = pg8::cvt_pk_bf16(O[dt][2] * inv, O[dt][3] * inv);
            *(u32x2*)(orow + 16 * dt + 4 * fq) = w;
        }
        if (fq == 0) lse[(size_t)(b * SEQ + ((64 * n + qi) << dsh) + r) * NHEADS + hh] = mx + __builtin_amdgcn_logf(sum);
        buf ^= 1;
    }
    __syncthreads();
#undef ATT_DECODE
#undef ATT_ISSUE
}

__device__ __forceinline__ void elem_phase(const Ptrs& F, bf16_t* P, const bf16_t* Ob, const bf16_t* ZA, const float* lse, int vcu, int G) {
    int tid_ = threadIdx.x; asm volatile("" : "+v"(tid_));
    const int tid = tid_, lane = tid & 63, wave = tid >> 6;
    f32x4 cw[2][4][2];
#pragma unroll
    for (int ii = 0; ii < 2; ++ii) { const int ch = 8 * (lane + 64 * ii);
#pragma unroll
        for (int t = 0; t < 3; ++t) { cw[ii][t][0] = *(const f32x4*)(F.conv_w + t * DM + ch); cw[ii][t][1] = *(const f32x4*)(F.conv_w + t * DM + ch + 4); }
        cw[ii][3][0] = *(const f32x4*)(F.conv_b + ch); cw[ii][3][1] = *(const f32x4*)(F.conv_b + ch + 4); }
    for (int rb = vcu; rb < MP / 16; rb += G) {
        const int row = rb * 16 + 2 * wave, s = row & (SEQ - 1);
        bf16_t* pr = P + (size_t)row * NP; const int bb = row >> 12;
#pragma unroll
        for (int ii = 0; ii < 2; ++ii) {
            const int ch = 8 * (lane + 64 * ii);
            float bz0[8], bz1[8], um[8], u0[8], u1[8], u2[8];
            const u32x4 z4 = (u32x4){0u, 0u, 0u, 0u};
            unpack8(__builtin_nontemporal_load((const u32x4*)(pr + OFF_BZ + ch)), bz0); unpack8(__builtin_nontemporal_load((const u32x4*)(pr + NP + OFF_BZ + ch)), bz1);
            unpack8(*(const u32x4*)(pr + OFF_U + ch), u0); unpack8(*(const u32x4*)(pr + NP + OFF_U + ch), u1);
            unpack8(s > 0 ? *(const u32x4*)(pr - NP + OFF_U + ch) : z4, um); unpack8(s + 1 < SEQ - 1 ? *(const u32x4*)(pr + 2 * NP + OFF_U + ch) : z4, u2);
            f32x4 y0[2], y1[2];
#pragma unroll
            for (int j = 0; j < 8; ++j) {
                const float w0 = cw[ii][0][j >> 2][j & 3], w1 = cw[ii][1][j >> 2][j & 3], w2 = cw[ii][2][j >> 2][j & 3], cb = cw[ii][3][j >> 2][j & 3];
                y0[j >> 2][j & 3] = bz0[j] * (um[j] * w0 + u0[j] * w1 + u1[j] * w2 + cb);
                y1[j >> 2][j & 3] = bz1[j] * (u0[j] * w0 + u1[j] * w1 + u2[j] * w2 + cb);
            }
            *(u32x4*)(pr + OFF_YC + ch) = pack8(y0[0], y0[1]);
            *(u32x4*)(pr + NP + OFF_YC + ch) = pack8(y1[0], y1[1]);
        }
        {
            const int h = lane >> 3, dc = (lane & 7) * 8;
#pragma unroll
            for (int rr = 0; rr < 2; ++rr) {
                const int sr = s + rr;
                const float* lp = lse + (size_t)(row + rr) * NHEADS + h;
                const float L0 = lp[0], L1 = lp[8], L2 = lp[16];
                const float mx = fmaxf(L0, fmaxf(L1, L2));
                float w0 = fast_exp2(L0 - mx), w1 = fast_exp2(L1 - mx), w2 = fast_exp2(L2 - mx);
                const float inv = fast_rcp(w0 + w1 + w2); w0 *= inv; w1 *= inv; w2 *= inv;
                float o0[8], o1[8], o2[8], za[8];
                const bf16_t* ob = Ob + ((size_t)(bb * NHEADS + h) * SEQ) * 64 + dc;
                unpack8(__builtin_nontemporal_load((const u32x4*)(ob + (size_t)sr * 64)), o0);
                unpack8(__builtin_nontemporal_load((const u32x4*)(ob + ((size_t)8 * SEQ + ((sr & 3) << 10) + (sr >> 2)) * 64)), o1);
                unpack8(__builtin_nontemporal_load((const u32x4*)(ob + ((size_t)16 * SEQ + ((sr & 15) << 8) + (sr >> 4)) * 64)), o2);
                unpack8(*(const u32x4*)(pr + rr * NP + OFF_ZA + h * 64 + dc), za);
                f32x4 y[2];
#pragma unroll
                for (int j = 0; j < 8; ++j) y[j >> 2][j & 3] = (w0 * o0[j] + w1 * o1[j] + w2 * o2[j]) * siluf_(za[j]);
                *(u32x4*)(pr + rr * NP + OFF_YA + h * 64 + dc) = pack8(y[0], y[1]);
            }
        }
    }
}

#define XB_TMO      128
#define XB_XCNT(j)  (256  + 64 * (j))
#define XB_XSUB(j)  (1280 + 64 * (j))
#define XB_XGEN(j)  (2304 + 64 * (j))
#define XB_TOP      3328
#define XB_TOPGEN   3392
#define XCD_BAR_WORDS 3456
#define XB_SPIN_CAP (1u << 18)

__device__ __forceinline__ unsigned xb_ld(unsigned* p)              { return __hip_atomic_load(p, __ATOMIC_RELAXED, __HIP_MEMORY_SCOPE_AGENT); }
__device__ __forceinline__ unsigned xb_add(unsigned* p, unsigned v) { return __hip_atomic_fetch_add(p, v, __ATOMIC_RELAXED, __HIP_MEMORY_SCOPE_AGENT); }
__device__ __forceinline__ unsigned xb_xcc_id() { return (unsigned)__builtin_amdgcn_s_getreg((3 << 11) | 20) & 0xFu; }
#define XB_SPIN(cond, bar) do { unsigned _sp = 0; while (cond) { __builtin_amdgcn_s_sleep(1); \
    if ((++_sp & 255u) == 0u) { if (xb_ld(&(bar)[XB_TMO])) break; if (_sp > XB_SPIN_CAP) { atomicAdd(&(bar)[XB_TMO], 1u); break; } } } } while (0)

struct XcdBarrier {
    unsigned* bar; unsigned x;
    volatile LAS unsigned* st;
};

__device__ __forceinline__ XcdBarrier xcd_barrier_post(unsigned* bar, volatile LAS unsigned* st) {
    XcdBarrier b; b.bar = bar; b.x = xb_xcc_id(); b.st = st;
    if (threadIdx.x == 0) (void)xb_add(&bar[XB_XCNT(b.x)], 1u);
    return b;
}
__device__ __forceinline__ void xcd_barrier_complete(unsigned* bar, unsigned x, unsigned& nloc, unsigned& nx) {
    const unsigned G = gridDim.x * gridDim.y * gridDim.z;
    unsigned sum, cnt, mine, sp = 0u;
    for (;;) {
        sum = 0u; cnt = 0u; mine = 0u;
#pragma unroll
        for (unsigned j = 0; j < 16; ++j) { const unsigned c = xb_ld(&bar[XB_XCNT(j)]); sum += c; cnt += (c > 0u) ? 1u : 0u; mine = (j == x) ? c : mine; }
        if (sum == G) break;
        __builtin_amdgcn_s_sleep(1);
        if ((++sp & 255u) == 0u) { if (xb_ld(&bar[XB_TMO])) break; if (sp > XB_SPIN_CAP) { atomicAdd(&bar[XB_TMO], 1u); break; } }
    }
    nloc = mine > 0u ? mine : 1u; nx = cnt > 0u ? cnt : 1u;
}

__device__ __forceinline__ void xcd_barrier(const XcdBarrier& b) {
    asm volatile("s_waitcnt vmcnt(0)" ::: "memory");
    __syncthreads();
    if (threadIdx.x == 0) {
        unsigned* bar = b.bar;
        __builtin_amdgcn_s_waitcnt(0);
        unsigned nloc = b.st[0], nx = b.st[1];
        if (nloc == 0u) { xcd_barrier_complete(bar, b.x, nloc, nx); b.st[0] = nloc; b.st[1] = nx; }
        const unsigned old = xb_add(&bar[XB_XSUB(b.x)], 1u);
        const unsigned gen = old / nloc;
        if (old + 1u == (gen + 1u) * nloc) {
            __builtin_amdgcn_fence(__ATOMIC_RELEASE, "agent");
            asm volatile("s_waitcnt vmcnt(0)" ::: "memory");
            const unsigned og = xb_add(&bar[XB_TOP], 1u);
            const unsigned tg = og / nx;
            if (og + 1u == (tg + 1u) * nx) xb_add(&bar[XB_TOPGEN], 1u);
            else XB_SPIN(xb_ld(&bar[XB_TOPGEN]) == tg, bar);
            __builtin_amdgcn_fence(__ATOMIC_ACQUIRE, "agent");
            xb_add(&bar[XB_XGEN(b.x)], 1u);
            asm volatile("s_waitcnt vmcnt(0)" ::: "memory");
        } else {
            XB_SPIN(xb_ld(&bar[XB_XGEN(b.x)]) == gen, bar);
            __builtin_amdgcn_fence(__ATOMIC_ACQUIRE, "agent");
            asm volatile("s_waitcnt vmcnt(0)" ::: "memory");
        }
    }
    __syncthreads();
}


struct Args { const float* in[10]; float* out; unsigned char* ws; int pad0, pad1; };

__global__ void __launch_bounds__(NTHREADS, 2) fwd_kernel(Args args) {
    extern __shared__ __attribute__((aligned(16))) unsigned char lds_raw[];
    LAS unsigned char* lds = (LAS unsigned char*)lds_raw;
    cg::grid_group grid = cg::this_grid();
    const int G = gridDim.x, bx = blockIdx.x;
    const int vcu = (G % 8 == 0) ? (bx % 8) * (G / 8) + bx / 8 : bx;
    unsigned char* ws = args.ws;
    Ptrs F;
    F.x = args.in[0]; F.norm_g = args.in[1]; F.w_in = args.in[2]; F.conv_w = args.in[3]; F.conv_b = args.in[4]; F.qg = args.in[5]; F.kg = args.in[6];
    F.wbc = args.in[7]; F.wba = args.in[8]; F.wout = args.in[9]; F.out = args.out;
    F.WinT = (bf16_t*)(ws + WS_WIN); F.WcatT = (bf16_t*)(ws + WS_WCAT); F.WoutT = (bf16_t*)(ws + WS_WOUT);
    F.XN = (bf16_t*)args.out;
    F.PROJ = (bf16_t*)(ws + WS_PROJ); F.Mb = F.PROJ + OFF_U; F.Qb = (bf16_t*)(ws + WS_Q); F.Kb = (bf16_t*)(ws + WS_K); F.Vb = (bf16_t*)(ws + WS_V); F.ZA = (bf16_t*)(ws + WS_ZA);
    F.rope = (float*)(ws + WS_ROPE); F.lse = (float*)(ws + WS_LSE);
    unsigned* barw = (unsigned*)(ws + WS_BAR);
    volatile LAS unsigned* st = (volatile LAS unsigned*)(lds + 131072);
    if (threadIdx.x < 64) st[threadIdx.x] = 0u;
    __syncthreads();
    XcdBarrier xbar = xcd_barrier_post(barw, st);
    if (args.pad0 != 0) grid.sync();

    prologue(F, lds, vcu, G);
    xcd_barrier(xbar);

    bf16_t* GC = (bf16_t*)(ws + WS_GC); bf16_t* GA = (bf16_t*)(ws + WS_GA);
    EpiProj EP{F.PROJ, F.Qb, F.ZA, GC, F.qg, F.kg, F.rope};
    if (((bx >> 3) & 1) != 0) late_transposes(F, lds, ((((bx >> 4) << 3) | (bx & 7)) * NWAVES) + (threadIdx.x >> 6), (G >> 1) * NWAVES);
    {
        pg8::Gemm g{F.XN, F.WinT, DM, DM, DM}; pg8::StaticOrder S; S.init(MP, 36 * 256, G, bx, 0);
        pg8::gemm_phase<EpiProj, pg8::StaticOrder>(lds, g, S, EP);
    }
    xcd_barrier(xbar);
    attn_phase(lds, F.Qb, F.Kb, F.Vb, F.Qb, F.lse, vcu, G);
    xcd_barrier(xbar);
    const bool elem_first = ((bx >> 3) & 1) != 0;
    if (elem_first) elem_phase(F, F.PROJ, F.Qb, F.ZA, F.lse, vcu, G);
    {
        pg8::Gemm g{F.XN, F.WinT, DM, DM, DM};
        pg8::StaticOrder S2; S2.init(MP, 8 * 256, G, bx, 36);
        pg8::gemm_phase<EpiProj, pg8::StaticOrder>(lds, g, S2, EP);
    }
    if (!elem_first) elem_phase(F, F.PROJ, F.Qb, F.ZA, F.lse, vcu, G);
    xcd_barrier(xbar);
    {
        pg8::Gemm g{F.PROJ, F.WcatT, NP, 1536, 1536}; pg8::StaticOrder S; S.init(MP, DM, G, bx);
        EpiMerge E{GC, GA, F.Mb};
        pg8::gemm_phase<EpiMerge, pg8::StaticOrder>(lds, g, S, E);
    }
    xcd_barrier(xbar);
    {
        pg8::Gemm g{F.Mb, F.WoutT, NP, DM, DM}; pg8::StaticOrder S; S.init(MP, DM, G, bx);
        EpiOut E{F.x, F.out};
        pg8::gemm_phase<EpiOut, pg8::StaticOrder>(lds, g, S, E);
    }
}

extern "C" void kernel_launch(void* const* d_in, const int* in_sizes, int n_in, void* d_out, int out_size, void* d_ws, size_t ws_size, hipStream_t stream) {
    static int grid = 0;
    if (grid == 0) {
        if (n_in != 10 || in_sizes[0] != MTOT * DM || out_size != MTOT * DM || ws_size < WS_END) {
            fprintf(stderr, "kernel_launch: unexpected shapes (n_in %d, in0 %d, out %d, ws %zu)\n", n_in, n_in > 0 ? in_sizes[0] : -1, out_size, ws_size); grid = -1; return; }
        int dev = 0, cus = 0, per_cu = 0;
        hipGetDevice(&dev);
        hipDeviceGetAttribute(&cus, hipDeviceAttributeMultiprocessorCount, dev);
        if (hipFuncSetAttribute((const void*)fwd_kernel, hipFuncAttributeMaxDynamicSharedMemorySize, LDS_BYTES) != hipSuccess) { fprintf(stderr, "kernel_launch: hipFuncSetAttribute failed\n"); grid = -1; return; }
        if (hipOccupancyMaxActiveBlocksPerMultiprocessor(&per_cu, (const void*)fwd_kernel, NTHREADS, LDS_BYTES) != hipSuccess || per_cu < 1) { fprintf(stderr, "kernel_launch: occupancy query failed (%d)\n", per_cu); per_cu = 1; }
        (void)hipGetLastError();
        grid = cus * per_cu;
    }
    if (grid < 0) return;
    if (hipMemsetAsync((char*)d_ws + WS_BAR, 0, XCD_BAR_WORDS * 4, stream) != hipSuccess) { fprintf(stderr, "kernel_launch: memset failed\n"); return; }
    Args a{};
    for (int i = 0; i < 10; ++i) a.in[i] = (const float*)d_in[i];
    a.out = (float*)d_out; a.ws = (unsigned char*)d_ws;
    void* kargs[] = {&a};
    hipError_t e = hipLaunchCooperativeKernel((const void*)fwd_kernel, dim3(grid), dim3(NTHREADS), kargs, LDS_BYTES, stream);
    if (e != hipSuccess) fprintf(stderr, "cooperative launch failed: %s (grid %d)\n", hipGetErrorString(e), grid);
}
```

```cpp
#include <hip/hip_runtime.h>
#include <hip/hip_cooperative_groups.h>
#include <cstdio>
#include <cstdint>
namespace cg = cooperative_groups;

#define LAS __attribute__((address_space(3)))
typedef unsigned short bf16_t;
typedef short bf16x8 __attribute__((ext_vector_type(8)));
typedef short s16x4 __attribute__((ext_vector_type(4)));
typedef float f32x4 __attribute__((ext_vector_type(4)));
typedef unsigned u32x4 __attribute__((ext_vector_type(4)));
typedef unsigned u32x2 __attribute__((ext_vector_type(2)));

constexpr int SEQ = 4096, DM = 1024, NBATCH = 8, MTOT = NBATCH * SEQ;
constexpr int MP = MTOT;
constexpr int NIN = 11264;
constexpr int NP = 2560;
constexpr int OFF_ZA = 0, OFF_BZ = 512, OFF_U = 1536;
constexpr int OFF_YA = OFF_ZA, OFF_YC = OFF_BZ;
constexpr int NHEADS = 24;
constexpr float NORM_EPS = 1e-6f;
constexpr float QSCALE = 0.125f * 1.4426950408889634f;

constexpr size_t MiB = 1u << 20;
constexpr size_t WS_WIN = 0;
constexpr size_t WS_WCAT = 22 * MiB;
constexpr size_t WS_WOUT = 25 * MiB;
constexpr size_t WS_ROPE = 27 * MiB;
constexpr size_t WS_LSE = 28 * MiB;
constexpr size_t WS_BAR = 31 * MiB;
constexpr size_t WS_Q = 32 * MiB;
constexpr size_t WS_K = 128 * MiB;
constexpr size_t WS_V = 224 * MiB;
constexpr size_t WS_GC = 128 * MiB;
constexpr size_t WS_GA = 192 * MiB;
constexpr size_t WS_PROJ = 320 * MiB;
constexpr size_t WS_ZA = 480 * MiB;
constexpr size_t WS_END = 480 * MiB;

static_assert(WS_V - WS_K == WS_K - WS_Q, "q/k/v spacing");
constexpr int NWAVES = 8, NTHREADS = 512;
constexpr int LDS_BYTES = 131072 + 1024;

namespace pg8 {
constexpr int BM = 256, BK = 64, HALF = 128, HTB = HALF * BK * 2, NXCD = 8, WGM = 8;
__host__ __device__ __forceinline__ int lds_byte(int r, int c) { const int st = (r >> 4) * 2 + (c >> 5), rr = r & 15, cc = c & 31, ob = rr * 64 + cc * 2; return st * 1024 + (ob ^ (((ob >> 9) & 1) << 5)); }
__host__ __device__ __forceinline__ void stage_rc(int b, int& R, int& C) { const int st = b / 1024, sb = b % 1024, swz = sb ^ (((sb >> 9) & 1) << 5); R = (st >> 1) * 16 + swz / 64; C = (st & 1) * 32 + (swz % 64) / 2; }
__host__ __device__ __forceinline__ int perm32(int rho) { const int n = rho >> 4, i = rho & 15; return 8 * (i >> 2) + 4 * n + (i & 3); }

struct Unit { int pm, pn; };
struct Gemm { const bf16_t* A; const bf16_t* Bt; int lda, ldb, K; };

struct StaticOrder {
    int nM, nN, nwg, G, c, pn0;
    __device__ void init(int M, int N, int G_, int c_, int pn0_ = 0) { nM = M / BM; nN = N / BM; nwg = nM * nN; G = G_; c = c_; pn0 = pn0_; }
    __device__ bool next(int i, Unit& u) const {
        const long L = (long)i * G + c; if (L >= nwg) return false;
        int wgid = (int)L; { const int q = nwg / NXCD, r = nwg % NXCD, xcd = wgid % NXCD, off = wgid / NXCD; wgid = (xcd < r ? xcd * (q + 1) : r * (q + 1) + (xcd - r) * q) + off; }
        const int nig = WGM * nN, gid = wgid / nig, fm = gid * WGM, gsz = (nM - fm) < WGM ? (nM - fm) : WGM;
        u.pm = fm + ((wgid % nig) % gsz); u.pn = pn0 + (wgid % nig) / gsz; return true;
    }
};

__device__ __forceinline__ unsigned cvt_pk_bf16(float lo, float hi) { unsigned r; asm volatile("v_cvt_pk_bf16_f32 %0, %1, %2" : "=v"(r) : "v"(lo), "v"(hi)); return r; }

template <class Epi, class Sched>
__device__ __forceinline__ void gemm_phase(LAS unsigned char* lds, const Gemm g, const Sched& S, const Epi& E) {
    int tid_ = threadIdx.x; asm volatile("" : "+v"(tid_));
    const int tid = tid_, wid = __builtin_amdgcn_readfirstlane(tid >> 6), lane = tid & 63, wr = wid >> 2, wc = wid & 3, fr = lane & 15, fq = lane >> 4;
    const int K = g.K, nt = K / BK;
    unsigned voffA[2], voffB[2];
#pragma unroll
    for (int i = 0; i < 2; ++i) { int R, C; stage_rc(tid * 16 + i * 8192, R, C); const int Rb = (R & ~31) + perm32(R & 31);
        voffA[i] = (unsigned)(R * g.lda + C) * 2u; voffB[i] = (unsigned)(Rb * g.ldb + C) * 2u; }
    const size_t kstep = (size_t)(BK * 2);
    const size_t hstepA = (size_t)HALF * g.lda * 2, hstepB = (size_t)HALF * g.ldb * 2;
    const size_t tstepA = 2 * hstepA, tstepB = 2 * hstepB;
    const unsigned ldsw = (unsigned)wid * 1024u;
    const int aoff = lds_byte(wr * 64 + fr, fq * 8), boff = lds_byte(wc * 32 + fr, fq * 8);
#define PG8_SA(b, h) (((b) * 2 + (h)) * HTB)
#define PG8_SB(b, h) ((4 + (b) * 2 + (h)) * HTB)
#define PG8_STAGE(bufoff, gbase, voff) do { _Pragma("unroll") for (int _i = 0; _i < 2; ++_i) \
        __builtin_amdgcn_global_load_lds((const unsigned*)((const char*)(gbase) + (voff)[_i]), (LAS unsigned*)(lds + (bufoff) + ldsw + _i * 8192), 16, 0, 0); } while (0)
#define PG8_LDA(dst, b, h) do { _Pragma("unroll") for (int m = 0; m < 4; ++m) _Pragma("unroll") for (int k = 0; k < 2; ++k) dst[m][k] = *(const LAS bf16x8*)(lds + PG8_SA(b, h) + aoff + m * 2048 + k * 1024); } while (0)
#define PG8_LDB(dst, b, h) do { _Pragma("unroll") for (int n = 0; n < 2; ++n) _Pragma("unroll") for (int k = 0; k < 2; ++k) dst[n][k] = *(const LAS bf16x8*)(lds + PG8_SB(b, h) + boff + n * 2048 + k * 1024); } while (0)
#define PG8_MMA(ai, bj, At, Bt) do { __builtin_amdgcn_s_setprio(1); _Pragma("unroll") for (int m = 0; m < 4; ++m) _Pragma("unroll") for (int n = 0; n < 2; ++n) _Pragma("unroll") for (int k = 0; k < 2; ++k) \
        acc[ai][bj][m][n] = __builtin_amdgcn_mfma_f32_16x16x32_bf16(Bt[n][k], At[m][k], acc[ai][bj][m][n], 0, 0, 0); __builtin_amdgcn_s_setprio(0); } while (0)
#define PG8_WAIT_V(n) asm volatile("s_waitcnt vmcnt(" #n ")" ::: "memory")
#define PG8_WAIT_L(n) asm volatile("s_waitcnt lgkmcnt(" #n ")" ::: "memory")
#define PG8_BAR __builtin_amdgcn_s_barrier()
#define PG8_SCHED __builtin_amdgcn_sched_barrier(0)
    Unit cur, nxt; int ui = 0;
    if (!S.next(0, cur)) return;
    f32x4 acc[2][2][4][2];
#pragma unroll
    for (int a = 0; a < 2; ++a)
#pragma unroll
        for (int b = 0; b < 2; ++b)
#pragma unroll
            for (int m = 0; m < 4; ++m)
#pragma unroll
                for (int n = 0; n < 2; ++n) acc[a][b][m][n] = (f32x4){0.f, 0.f, 0.f, 0.f};
    bf16x8 At[4][2], B0[2][2], B1[2][2];
    const char* cA = (const char*)g.A + (size_t)cur.pm * tstepA; const char* cB = (const char*)g.Bt + (size_t)cur.pn * tstepB;
    PG8_STAGE(PG8_SB(0, 0), cB, voffB); PG8_STAGE(PG8_SB(0, 1), cB + hstepB, voffB); PG8_STAGE(PG8_SA(0, 0), cA, voffA); PG8_STAGE(PG8_SA(0, 1), cA + hstepA, voffA);
    if (wr == 1) PG8_BAR;
    PG8_WAIT_V(2); PG8_BAR;
    PG8_STAGE(PG8_SB(1, 0), cB + kstep, voffB); PG8_STAGE(PG8_SA(1, 0), cA + kstep, voffA); PG8_STAGE(PG8_SB(1, 1), cB + hstepB + kstep, voffB);
    PG8_WAIT_V(6); PG8_BAR;
    for (;;) {
        const bool has_next = S.next(ui + 1, nxt);
        const char* nA = has_next ? (const char*)g.A + (size_t)nxt.pm * tstepA : cA; const char* nB = has_next ? (const char*)g.Bt + (size_t)nxt.pn * tstepB : cB;
        for (int t = 0; t < nt; t += 2) {
            const bool last = (t == nt - 2);
            const char* a1 = cA + (size_t)(t + 1) * kstep;
            const char* a2 = last ? nA : cA + (size_t)(t + 2) * kstep; const char* b2 = last ? nB : cB + (size_t)(t + 2) * kstep;
            const char* a3 = a2 + kstep; const char* b3 = b2 + kstep;
            if constexpr (Epi::MIDK > 0) { if (t == Epi::MIDK) E.mid(acc, cur, wr, wc, fr, fq); }
            PG8_LDB(B0, 0, 0); PG8_LDB(B1, 0, 1); PG8_SCHED; PG8_LDA(At, 0, 0); PG8_STAGE(PG8_SA(1, 1), a1 + hstepA, voffA);
            PG8_WAIT_V(8); PG8_WAIT_L(0); PG8_BAR; PG8_MMA(0, 0, At, B0); PG8_MMA(0, 1, At, B1); PG8_BAR; PG8_SCHED;
            PG8_LDA(At, 0, 1); PG8_STAGE(PG8_SB(0, 0), b2, voffB); PG8_STAGE(PG8_SB(0, 1), b2 + hstepB, voffB); PG8_STAGE(PG8_SA(0, 0), a2, voffA);
            PG8_WAIT_V(8); PG8_WAIT_L(0); PG8_BAR; PG8_MMA(1, 0, At, B0); PG8_MMA(1, 1, At, B1); PG8_BAR; PG8_SCHED;
            PG8_LDB(B0, 1, 0); PG8_LDB(B1, 1, 1); PG8_SCHED; PG8_LDA(At, 1, 0); PG8_STAGE(PG8_SA(0, 1), a2 + hstepA, voffA);
            PG8_WAIT_V(8); PG8_WAIT_L(0); PG8_BAR; PG8_MMA(0, 0, At, B0); PG8_MMA(0, 1, At, B1); PG8_BAR; PG8_SCHED;
            PG8_LDA(At, 1, 1); PG8_STAGE(PG8_SB(1, 0), b3, voffB); PG8_STAGE(PG8_SB(1, 1), b3 + hstepB, voffB); PG8_STAGE(PG8_SA(1, 0), a3, voffA);
            PG8_WAIT_V(8); PG8_WAIT_L(0); PG8_BAR; PG8_MMA(1, 0, At, B0); PG8_MMA(1, 1, At, B1); PG8_BAR; PG8_SCHED;
        }
        if (wr == 0) PG8_BAR;
        E(acc, cur, wr, wc, fr, fq);
        if (!has_next) break;
#pragma unroll
        for (int a = 0; a < 2; ++a)
#pragma unroll
            for (int b = 0; b < 2; ++b)
#pragma unroll
                for (int m = 0; m < 4; ++m)
#pragma unroll
                    for (int n = 0; n < 2; ++n) acc[a][b][m][n] = (f32x4){0.f, 0.f, 0.f, 0.f};
        cur = nxt; cA = nA; cB = nB; ++ui;
        if (wr == 1) PG8_BAR;
    }
    PG8_WAIT_V(0);
    PG8_BAR;
#undef PG8_SA
#undef PG8_SB
#undef PG8_STAGE
#undef PG8_LDA
#undef PG8_LDB
#undef PG8_MMA
#undef PG8_WAIT_V
#undef PG8_WAIT_L
#undef PG8_BAR
#undef PG8_SCHED
}
}

__device__ __forceinline__ float bf_lo(unsigned w) { return __uint_as_float(w << 16); }
__device__ __forceinline__ float bf_hi(unsigned w) { return __uint_as_float(w & 0xffff0000u); }
__device__ __forceinline__ float fast_rcp(float x) { return __builtin_amdgcn_rcpf(x); }
__device__ __forceinline__ float fast_exp2(float x) { return __builtin_amdgcn_exp2f(x); }
__device__ __forceinline__ float sigmoidf_(float x) { return fast_rcp(1.f + fast_exp2(-1.4426950408889634f * x)); }
__device__ __forceinline__ float siluf_(float x) { return x * sigmoidf_(x); }
__device__ __forceinline__ u32x4 pack8(const f32x4 a, const f32x4 b) {
    u32x4 w; w.x = pg8::cvt_pk_bf16(a[0], a[1]); w.y = pg8::cvt_pk_bf16(a[2], a[3]); w.z = pg8::cvt_pk_bf16(b[0], b[1]); w.w = pg8::cvt_pk_bf16(b[2], b[3]); return w;
}
__device__ __forceinline__ void unpack8(const u32x4 w, float (&f)[8]) {
    f[0] = bf_lo(w.x); f[1] = bf_hi(w.x); f[2] = bf_lo(w.y); f[3] = bf_hi(w.y); f[4] = bf_lo(w.z); f[5] = bf_hi(w.z); f[6] = bf_lo(w.w); f[7] = bf_hi(w.w);
}
__device__ __forceinline__ float wave_sum(float v) {
#pragma unroll
    for (int o = 1; o < 64; o <<= 1) v += __shfl_xor(v, o);
    return v;
}

struct EpiProj {
    static constexpr int MIDK = 0;
    bf16_t* P; bf16_t* Qb; bf16_t* ZA; bf16_t* GCp; const float* qg; const float* kg; const float* rope;
    __device__ __forceinline__ void operator()(const f32x4 (&acc)[2][2][4][2], const pg8::Unit& u, int wr, int wc, int fr, int fq) const {
        const int pn = u.pn;
        const int row0 = u.pm * 256 + wr * 64 + fr;
        if (pn >= 16 && pn < 34) {
            const int sel = pn < 22 ? 0 : (pn < 28 ? 1 : 2);
            const int hh = (pn - 16 - 6 * sel) * 4 + wc, dsh = 2 * (hh >> 3);
            bf16_t* base = Qb + (size_t)sel * ((WS_K - WS_Q) / 2) + (size_t)hh * (SEQ * 64) + 8 * fq;
            if (sel < 2) {
                const float* gp = sel == 0 ? qg : kg;
                const float sc = sel == 0 ? QSCALE : 1.f;
                const f32x4 g00 = *(const f32x4*)(gp + 8 * fq), g01 = *(const f32x4*)(gp + 8 * fq + 4), g10 = *(const f32x4*)(gp + 32 + 8 * fq), g11 = *(const f32x4*)(gp + 36 + 8 * fq);
#pragma unroll
                for (int ai = 0; ai < 2; ++ai)
#pragma unroll
                    for (int m = 0; m < 4; ++m) {
                        float ss = 0.f;
#pragma unroll
                        for (int bj = 0; bj < 2; ++bj)
#pragma unroll
                            for (int n = 0; n < 2; ++n) { const f32x4 x = acc[ai][bj][m][n]; ss += (x[0] * x[0] + x[1] * x[1]) + (x[2] * x[2] + x[3] * x[3]); }
                        ss += __shfl_xor(ss, 16); ss += __shfl_xor(ss, 32);
                        const float rinv = rsqrtf(ss * (1.f / 64.f) + NORM_EPS) * sc;
                        const int row = row0 + ai * 128 + m * 16, pos = row & (SEQ - 1), bb = row >> 12;
                        const int p = ((pos & ((1 << dsh) - 1)) << (12 - dsh)) + (pos >> dsh);
                        const float* rp = rope + pos * 64 + 8 * fq;
                        f32x4 o1[2], o2[2];
#pragma unroll
                        for (int n = 0; n < 2; ++n) {
                            const f32x4 c = *(const f32x4*)(rp + 4 * n), sn = *(const f32x4*)(rp + 32 + 4 * n);
                            const f32x4 t1 = acc[ai][0][m][n] * rinv * (n == 0 ? g00 : g01), t2 = acc[ai][1][m][n] * rinv * (n == 0 ? g10 : g11);
                            o1[n] = t1 * c - t2 * sn; o2[n] = t2 * c + t1 * sn;
                        }
                        bf16_t* dst = base + ((size_t)bb * (NHEADS * SEQ) + p) * 64;
                        __builtin_nontemporal_store(pack8(o1[0], o1[1]), (u32x4*)dst);
                        __builtin_nontemporal_store(pack8(o2[0], o2[1]), (u32x4*)(dst + 32));
                    }
            } else {
#pragma unroll
                for (int ai = 0; ai < 2; ++ai)
#pragma unroll
                    for (int m = 0; m < 4; ++m) {
                        const int row = row0 + ai * 128 + m * 16, pos = row & (SEQ - 1), bb = row >> 12;
                        const int p = ((pos & ((1 << dsh) - 1)) << (12 - dsh)) + (pos >> dsh);
                        bf16_t* dst = base + ((size_t)bb * (NHEADS * SEQ) + p) * 64;
                        __builtin_nontemporal_store(pack8(acc[ai][0][m][0], acc[ai][0][m][1]), (u32x4*)dst);
                        __builtin_nontemporal_store(pack8(acc[ai][1][m][0], acc[ai][1][m][1]), (u32x4*)(dst + 32));
                    }
            }
        } else {
            if (pn < 16) {
                const bool isu = pn < 8;
                const int cb = (isu ? OFF_U : OFF_BZ) + 128 * (pn & 7) + 32 * wc + 8 * fq;
#pragma unroll
                for (int ai = 0; ai < 2; ++ai)
#pragma unroll
                    for (int m = 0; m < 4; ++m) {
                        f32x4 v0 = acc[ai][0][m][0], v1 = acc[ai][0][m][1];
                        const f32x4 y0 = acc[ai][1][m][0], y1 = acc[ai][1][m][1];
                        if (isu) { v0 *= y0; v1 *= y1; }
                        else {
#pragma unroll
                            for (int j = 0; j < 4; ++j) { v0[j] *= siluf_(y0[j]); v1[j] *= siluf_(y1[j]); }
                        }
                        __builtin_nontemporal_store(pack8(v0, v1), (u32x4*)(P + (size_t)(row0 + ai * 128 + m * 16) * NP + cb));
                    }
            } else {
                if (pn >= 36) {
                    const int gcol = 128 * (pn - 36) + 32 * wc + 8 * fq;
#pragma unroll
                    for (int ai = 0; ai < 2; ++ai)
#pragma unroll
                        for (int m = 0; m < 4; ++m) {
                            const size_t go = (size_t)(row0 + ai * 128 + m * 16) * 1024 + gcol;
                            f32x4 sc[2], rho[2];
#pragma unroll
                            for (int n = 0; n < 2; ++n)
#pragma unroll
                                for (int j = 0; j < 4; ++j) {
                                    const float ec = fminf(fast_exp2(-1.4426950408889634f * acc[ai][0][m][n][j]), 1e30f), ea = fast_exp2(-1.4426950408889634f * acc[ai][1][m][n][j]);
                                    sc[n][j] = fast_rcp(1.f + ec); rho[n][j] = (1.f + ec) * fast_rcp(1.f + ea);
                                }
                            *(u32x4*)(GCp + go) = pack8(sc[0], sc[1]);
                            *(u32x4*)(GCp + (WS_GA - WS_GC) / 2 + go) = pack8(rho[0], rho[1]);
                        }
                    return;
                }
                bf16_t* base = P + OFF_ZA + (pn - 34) * 256 + wc * 64 + 8 * fq;
#pragma unroll
                for (int ai = 0; ai < 2; ++ai)
#pragma unroll
                    for (int m = 0; m < 4; ++m) {
                        bf16_t* dst = base + (size_t)(row0 + ai * 128 + m * 16) * NP;
                        __builtin_nontemporal_store(pack8(acc[ai][0][m][0], acc[ai][0][m][1]), (u32x4*)dst);
                        __builtin_nontemporal_store(pack8(acc[ai][1][m][0], acc[ai][1][m][1]), (u32x4*)(dst + 32));
                    }
            }
        }
    }
};

struct EpiGate {
    static constexpr int MIDK = 0;
    bf16_t* Gx;
    __device__ __forceinline__ void operator()(const f32x4 (&acc)[2][2][4][2], const pg8::Unit& u, int wr, int wc, int fr, int fq) const {
        const int row0 = u.pm * 256 + wr * 64 + fr, col0 = u.pn * 256 + wc * 32 + 8 * fq;
#pragma unroll
        for (int ai = 0; ai < 2; ++ai)
#pragma unroll
            for (int m = 0; m < 4; ++m) {
                bf16_t* dst = Gx + (size_t)(row0 + ai * 128 + m * 16) * 1024 + col0;
#pragma unroll
                for (int bj = 0; bj < 2; ++bj) {
                    f32x4 v0 = acc[ai][bj][m][0], v1 = acc[ai][bj][m][1];
#pragma unroll
                    for (int j = 0; j < 4; ++j) { v0[j] = sigmoidf_(v0[j]); v1[j] = sigmoidf_(v1[j]); }
                    *(u32x4*)(dst + bj * 128) = pack8(v0, v1);
                }
            }
    }
};

struct EpiMerge {
    static constexpr int MIDK = 8;
    const bf16_t* GC; const bf16_t* GA; bf16_t* Mb;
    __device__ __forceinline__ void mid(f32x4 (&acc)[2][2][4][2], const pg8::Unit& u, int wr, int wc, int fr_, int fq_) const {
        int fr = fr_, fq = fq_; asm volatile("" : "+v"(fr), "+v"(fq));
        const int row0 = u.pm * 256 + wr * 64 + fr, col0 = u.pn * 256 + wc * 32 + 8 * fq;
#pragma unroll
        for (int ai = 0; ai < 2; ++ai)
#pragma unroll
            for (int m = 0; m < 4; ++m) {
                const size_t go = (size_t)(row0 + ai * 128 + m * 16) * 1024 + col0;
#pragma unroll
                for (int bj = 0; bj < 2; ++bj) {
                    float rh[8]; unpack8(__builtin_nontemporal_load((const u32x4*)(GA + go + bj * 128)), rh);
#pragma unroll
                    for (int j = 0; j < 4; ++j) { acc[ai][bj][m][0][j] *= rh[j]; acc[ai][bj][m][1][j] *= rh[4 + j]; }
                }
                __builtin_amdgcn_sched_barrier(0);
            }
    }
    __device__ __forceinline__ void operator()(const f32x4 (&acc)[2][2][4][2], const pg8::Unit& u, int wr, int wc, int fr, int fq) const {
        const int row0 = u.pm * 256 + wr * 64 + fr, col0 = u.pn * 256 + wc * 32 + 8 * fq;
#pragma unroll
        for (int ai = 0; ai < 2; ++ai) {
            u32x4 g[4][2];
#pragma unroll
            for (int m = 0; m < 4; ++m)
#pragma unroll
                for (int bj = 0; bj < 2; ++bj) g[m][bj] = *(const u32x4*)(GC + (size_t)(row0 + ai * 128 + m * 16) * 1024 + col0 + bj * 128);
            __builtin_amdgcn_sched_barrier(0);
#pragma unroll
            for (int m = 0; m < 4; ++m) {
                const int row = row0 + ai * 128 + m * 16;
#pragma unroll
                for (int bj = 0; bj < 2; ++bj) {
                    const int col = col0 + bj * 128;
                    float gc[8]; unpack8(g[m][bj], gc);
                    f32x4 v0 = acc[ai][bj][m][0], v1 = acc[ai][bj][m][1];
#pragma unroll
                    for (int j = 0; j < 4; ++j) { v0[j] *= gc[j]; v1[j] *= gc[4 + j]; }
                    *(u32x4*)(Mb + (size_t)row * NP + col) = pack8(v0, v1);
                }
            }
            __builtin_amdgcn_sched_barrier(0);
        }
    }
};

struct EpiOut {
    static constexpr int MIDK = 0;
    const float* X; float* O;
    __device__ __forceinline__ void operator()(const f32x4 (&acc)[2][2][4][2], const pg8::Unit& u, int wr, int wc, int fr, int fq) const {
        const int row0 = u.pm * 256 + wr * 64 + fr, col0 = u.pn * 256 + wc * 32 + 8 * fq;
#pragma unroll
        for (int ai = 0; ai < 2; ++ai)
#pragma unroll
            for (int m = 0; m < 4; ++m) {
                const int row = row0 + ai * 128 + m * 16;
#pragma unroll
                for (int bj = 0; bj < 2; ++bj) {
                    const size_t o = (size_t)row * DM + col0 + bj * 128;
                    const f32x4 x0 = __builtin_nontemporal_load((const f32x4*)(X + o)), x1 = __builtin_nontemporal_load((const f32x4*)(X + o + 4));
                    __builtin_nontemporal_store(x0 + acc[ai][bj][m][0], (f32x4*)(O + o)); __builtin_nontemporal_store(x1 + acc[ai][bj][m][1], (f32x4*)(O + o + 4));
                }
                __builtin_amdgcn_sched_barrier(0);
            }
    }
};

__device__ const double INVF[32] = {1.0, 0.7498942613601685, 0.5623413324356079, 0.4216965138912201, 0.3162277638912201, 0.23713737726211548, 0.17782793939113617, 0.133352130651474,
    0.10000000149011612, 0.07498941570520401, 0.05623413249850273, 0.04216965287923813, 0.03162277489900589, 0.023713737726211548, 0.017782794311642647, 0.01333521492779255,
    0.009999999776482582, 0.007498941849917173, 0.005623413249850273, 0.0042169648222625256, 0.003162277629598975, 0.00237137358635664, 0.0017782794311642647, 0.0013335214462131262,
    0.0010000000474974513, 0.0007498942431993783, 0.000562341301701963, 0.0004216965171508491, 0.0003162277571391314, 0.00023713737027719617, 0.00017782794020604342, 0.0001333521504420787};

__device__ __forceinline__ void transpose_item(const float* W, int ldw, int N, bf16_t* WT, int k0, int kd0, int n_src, int n_dst, LAS float* scr, int lane) {
    f32x4 wv[8];
#pragma unroll
    for (int i = 0; i < 8; ++i) wv[i] = __builtin_nontemporal_load((const f32x4*)(W + (size_t)(k0 + 8 * i + (lane >> 3)) * N + n_src + 4 * (lane & 7)));
#pragma unroll
    for (int i = 0; i < 8; ++i) { LAS float* d = scr + (8 * i + (lane >> 3)) * 33 + 4 * (lane & 7); d[0] = wv[i][0]; d[1] = wv[i][1]; d[2] = wv[i][2]; d[3] = wv[i][3]; }
    asm volatile("s_waitcnt lgkmcnt(0)" ::: "memory");
    const int c = lane & 7;
#pragma unroll
    for (int j = 0; j < 4; ++j) { const int n = (lane >> 3) + 8 * j; const LAS float* s = scr + (8 * c) * 33 + n;
        u32x4 o; o.x = pg8::cvt_pk_bf16(s[0 * 33], s[1 * 33]); o.y = pg8::cvt_pk_bf16(s[2 * 33], s[3 * 33]); o.z = pg8::cvt_pk_bf16(s[4 * 33], s[5 * 33]); o.w = pg8::cvt_pk_bf16(s[6 * 33], s[7 * 33]);
        *(u32x4*)(WT + (size_t)(n_dst + n) * ldw + kd0 + 8 * c) = o; }
    asm volatile("s_waitcnt lgkmcnt(0)" ::: "memory");
}

struct Ptrs {
    const float *x, *norm_g, *w_in, *conv_w, *conv_b, *qg, *kg, *wbc, *wba, *wout;
    float* out;
    bf16_t *WinT, *WcatT, *WoutT, *XN, *Mb, *PROJ, *Qb, *Kb, *Vb, *ZA;
    float *rope, *lse;
};

__device__ __forceinline__ void prologue(const Ptrs& F, LAS unsigned char* lds, int vcu, int G) {
    const int tid = threadIdx.x, lane = tid & 63, wave = tid >> 6;
    LAS float* scr = (LAS float*)(lds + wave * 16384);
    const int gw = vcu * NWAVES + wave, NGW = G * NWAVES;
    constexpr int NB_E = 36 * 8, I_E = 16 * NB_E;
    for (int it = gw; it < I_E; it += NGW) {
        const int nb = it % NB_E, kb = it / NB_E; const int nd = nb * 32;
        const int tile = nd >> 8, gidx = (nd & 255) >> 5, bj = gidx >> 2, wc = gidx & 3;
        const int ns = tile < 8 ? (bj ? 2048 : 1024) + 128 * tile + 32 * wc
                     : tile < 16 ? (bj ? 3072 : 0) + 128 * (tile - 8) + 32 * wc
                     : tile * 256 + wc * 64 + bj * 32;
        transpose_item(F.w_in, DM, NIN, F.WinT, kb * 64, kb * 64, ns, nd, scr, lane);
    }
    for (int m = gw; m < MTOT; m += 2 * NGW) {
        const int m2 = m + NGW;
        const bool has2 = m2 < MTOT;
        const f32x4* xr = (const f32x4*)(F.x + (size_t)m * DM) + lane;
        const f32x4* xr2 = (const f32x4*)(F.x + (size_t)(has2 ? m2 : m) * DM) + lane;
        const f32x4* gr = (const f32x4*)F.norm_g + lane;
        f32x4 v[4], w[4]; float s = 0.f, s2 = 0.f;
#pragma unroll
        for (int j = 0; j < 4; ++j) { v[j] = __builtin_nontemporal_load(xr + 64 * j); w[j] = __builtin_nontemporal_load(xr2 + 64 * j); }
#pragma unroll
        for (int j = 0; j < 4; ++j) { s += (v[j][0] * v[j][0] + v[j][1] * v[j][1]) + (v[j][2] * v[j][2] + v[j][3] * v[j][3]); s2 += (w[j][0] * w[j][0] + w[j][1] * w[j][1]) + (w[j][2] * w[j][2] + w[j][3] * w[j][3]); }
        const float rinv = rsqrtf(wave_sum(s) * (1.f / DM) + NORM_EPS), rinv2 = rsqrtf(wave_sum(s2) * (1.f / DM) + NORM_EPS);
        u32x2* o8 = (u32x2*)(F.XN + (size_t)m * DM) + lane;
        u32x2* o82 = (u32x2*)(F.XN + (size_t)m2 * DM) + lane;
#pragma unroll
        for (int j = 0; j < 4; ++j) { const f32x4 gg = gr[64 * j]; const f32x4 y = v[j] * rinv * gg, y2 = w[j] * rinv2 * gg;
            u32x2 p; p.x = pg8::cvt_pk_bf16(y[0], y[1]); p.y = pg8::cvt_pk_bf16(y[2], y[3]); o8[64 * j] = p;
            if (has2) { u32x2 q; q.x = pg8::cvt_pk_bf16(y2[0], y2[1]); q.y = pg8::cvt_pk_bf16(y2[2], y2[3]); o82[64 * j] = q; } }
    }
    for (int e = vcu * NTHREADS + tid; e < SEQ * 32; e += G * NTHREADS) {
        const int pos = e >> 5, i = e & 31;
        const double a = (double)(float)((float)pos * (float)INVF[i]);
        const double k = __builtin_rint(a * 0.15915494309189535);
        const double r = a - k * 6.283185307179586476925;
        const double r2 = r * r;
        double sn = 0.0, cs = 0.0;
#pragma unroll
        for (int n = 13; n >= 0; --n) {
            sn = 1.0 - sn * r2 * (1.0 / (double)((2 * n + 2) * (2 * n + 3)));
            cs = 1.0 - cs * r2 * (1.0 / (double)((2 * n + 1) * (2 * n + 2)));
        }
        F.rope[pos * 64 + i] = (float)cs; F.rope[pos * 64 + 32 + i] = (float)(sn * r);
    }
}

__device__ __forceinline__ void late_transposes(const Ptrs& F, LAS unsigned char* lds, int hw, int NHW) {
    const int tid = threadIdx.x, lane = tid & 63, wave = tid >> 6;
    LAS float* scr = (LAS float*)(lds + wave * 16384);
    constexpr int I_G = 16 * 64, I_BC = 16 * 32, I_BA = 8 * 32, I_OUT = 16 * 32, NL = I_G + I_BC + I_BA + I_OUT;
    for (int it = hw; it < NL; it += NHW) {
        int r = it;
        if (r < I_G) { const int nb = 36 * 8 + r % 64, kb = r / 64, nd = nb * 32; const int tile = nd >> 8, gidx = (nd & 255) >> 5, bj = gidx >> 2, wc = gidx & 3;
            transpose_item(F.w_in, DM, NIN, F.WinT, kb * 64, kb * 64, (bj ? 10240 : 9216) + 128 * (tile - 36) + 32 * wc, nd, scr, lane); continue; }
        r -= I_G;
        if (r < I_BC) { transpose_item(F.wbc, 1536, DM, F.WcatT, (r / 32) * 64, 512 + (r / 32) * 64, (r % 32) * 32, (r % 32) * 32, scr, lane); continue; }
        r -= I_BC;
        if (r < I_BA) { transpose_item(F.wba, 1536, DM, F.WcatT, (r / 32) * 64, (r / 32) * 64, (r % 32) * 32, (r % 32) * 32, scr, lane); continue; }
        r -= I_BA;
        transpose_item(F.wout, 1024, DM, F.WoutT, (r / 32) * 64, (r / 32) * 64, (r % 32) * 32, (r % 32) * 32, scr, lane);
    }
    __syncthreads();
}

__device__ __forceinline__ void attn_phase(LAS unsigned char* lds, const bf16_t* Qb, const bf16_t* Kb, const bf16_t* Vb, bf16_t* Ob, float* lse, int vcu, int G) {
    int tid_ = threadIdx.x; asm volatile("" : "+v"(tid_));
    const int tid = tid_, wid = __builtin_amdgcn_readfirstlane(tid >> 6), lane = tid & 63, fr = lane & 15, fq = lane >> 4;
    const int usel = wid >> 2, w4 = wid & 3;
    constexpr int NPAIR = (MP / SEQ) * NHEADS * 32;
    const int t0 = w4;
    const int dma_off = (lane >> 3) * 64 + (((lane & 7) ^ (((lane >> 4) & 3) << 1)) * 8);
    const int fk = ((fr >> 1) & 3) << 1;
    const int krow = 64 * usel + 16 * t0 + fr;
    const int koff0 = krow * 128 + ((fq ^ fk) * 16), koff1 = krow * 128 + (((fq + 4) ^ fk) * 16);
    const int fvh = (2 * fq + (fr >> 3)) & 3;
    const int vbase = 32768 + (64 * usel + 16 * t0 + 4 * fq + (fr >> 2)) * 128 + ((fr >> 1) & 1) * 16 + (fr & 1) * 8;
    const int qi = 16 * w4 + fr;
#define ATT_DECODE(IT, b_, hh_, dsh_, r_, n0_, L_) const int idx0_##IT = ((IT) & 31) * 2, bh_##IT = (IT) >> 5, hh_ = bh_##IT % NHEADS, b_ = bh_##IT / NHEADS, dsh_ = 2 * (hh_ >> 3), \
        r_ = idx0_##IT >> (6 - dsh_), n0_ = idx0_##IT & ((1 << (6 - dsh_)) - 1), L_ = SEQ >> dsh_
#define ATT_ISSUE(rowbase, buf) do { const bf16_t* kg_ = Kb + (long)(rowbase) * 64 + dma_off; const bf16_t* vg_ = Vb + (long)(rowbase) * 64 + dma_off; \
        _Pragma("unroll") for (int jj_ = 0; jj_ < 4; ++jj_) { const int j_ = wid + 8 * jj_; \
            __builtin_amdgcn_global_load_lds((const unsigned*)(kg_ + j_ * 512), (LAS unsigned*)(lds + (buf) * 65536 + j_ * 1024), 16, 0, 0); \
            __builtin_amdgcn_global_load_lds((const unsigned*)(vg_ + j_ * 512), (LAS unsigned*)(lds + (buf) * 65536 + 32768 + j_ * 1024), 16, 0, 0); } } while (0)
    f32x4 band0, band8;
#pragma unroll
    for (int i = 0; i < 4; ++i) { const int r0 = 4 * fq + i - fr, r8 = 128 + 4 * fq + i - fr; band0[i] = r0 >= 0 ? 0.f : -INFINITY; band8[i] = r8 <= 128 ? 0.f : -INFINITY; }
    int it = vcu, buf = 0;
    bf16x8 Qn0 = (bf16x8){0, 0, 0, 0, 0, 0, 0, 0}, Qn1 = Qn0;
    if (it < NPAIR) {
        ATT_DECODE(it, b, hh, dsh, r, n0, L);
        const long rb = (long)(b * NHEADS + hh) * SEQ + r * L + 64 * n0;
        ATT_ISSUE(rb - 64, 0);
        const bf16_t* qrow = Qb + (rb + 64 * usel + qi) * 64;
        Qn0 = *(const bf16x8*)(qrow + 8 * fq); Qn1 = *(const bf16x8*)(qrow + 32 + 8 * fq);
    }
    for (; it < NPAIR; it += G) {
        ATT_DECODE(it, b, hh, dsh, r, n0, L);
        const long rb = (long)(b * NHEADS + hh) * SEQ + r * L + 64 * n0;
        const int n = n0 + usel;
        const bf16x8 Qf0 = Qn0, Qf1 = Qn1;
        asm volatile("s_waitcnt vmcnt(0)" ::: "memory");
        __syncthreads();
        const int itn = it + G;
        if (itn < NPAIR) {
            ATT_DECODE(itn, b2, hh2, dsh2, r2, n02, L2);
            const long rb2 = (long)(b2 * NHEADS + hh2) * SEQ + r2 * L2 + 64 * n02;
            ATT_ISSUE(rb2 - 64, buf ^ 1);
            const bf16_t* qrow2 = Qb + (rb2 + 64 * usel + qi) * 64;
            Qn0 = *(const bf16x8*)(qrow2 + 8 * fq); Qn1 = *(const bf16x8*)(qrow2 + 32 + 8 * fq);
        }
        const LAS unsigned char* kb = lds + buf * 65536;
        f32x4 S[9];
#pragma unroll
        for (int t = 0; t < 9; ++t) {
            const bf16x8 k0 = *(const LAS bf16x8*)(kb + koff0 + t * 2048), k1 = *(const LAS bf16x8*)(kb + koff1 + t * 2048);
            f32x4 sv = (f32x4){0.f, 0.f, 0.f, 0.f};
            sv = __builtin_amdgcn_mfma_f32_16x16x32_bf16(k0, Qf0, sv, 0, 0, 0);
            sv = __builtin_amdgcn_mfma_f32_16x16x32_bf16(k1, Qf1, sv, 0, 0, 0);
            S[t] = sv;
        }
        if (n == 0 || 64 * n + 128 > L) {
#pragma unroll
            for (int t = 0; t < 9; ++t)
#pragma unroll
                for (int i = 0; i < 4; ++i) { const int l = 64 * n - 64 + 16 * (t0 + t) + 4 * fq + i; if ((unsigned)l >= (unsigned)L) S[t][i] = -INFINITY; }
        }
        float mx = -INFINITY;
        S[0] += band0; S[8] += band8;
#pragma unroll
        for (int t = 0; t < 9; ++t) mx = fmaxf(fmaxf(mx, fmaxf(S[t][0], S[t][1])), fmaxf(S[t][2], S[t][3]));
        mx = fmaxf(mx, __shfl_xor(mx, 16)); mx = fmaxf(mx, __shfl_xor(mx, 32));
        float sum = 0.f;
#pragma unroll
        for (int t = 0; t < 9; ++t) {
            typedef float f32x2 __attribute__((ext_vector_type(2)));
            const f32x2 mm = (f32x2){mx, mx};
            f32x2 lo = (f32x2){S[t][0], S[t][1]}, hi = (f32x2){S[t][2], S[t][3]};
            asm("v_pk_add_f32 %0, %1, %2 neg_lo:[0,1] neg_hi:[0,1]" : "=v"(lo) : "v"(lo), "v"(mm));
            asm("v_pk_add_f32 %0, %1, %2 neg_lo:[0,1] neg_hi:[0,1]" : "=v"(hi) : "v"(hi), "v"(mm));
            const float p0 = fast_exp2(lo[0]), p1 = fast_exp2(lo[1]), p2 = fast_exp2(hi[0]), p3 = fast_exp2(hi[1]);
            S[t] = (f32x4){p0, p1, p2, p3}; sum += (p0 + p1) + (p2 + p3);
        }
        sum += __shfl_xor(sum, 16); sum += __shfl_xor(sum, 32);
        bf16x8 Pf[4];
#pragma unroll
        for (int pp = 0; pp < 4; ++pp) {
            u32x4 w; w.x = pg8::cvt_pk_bf16(S[2 * pp][0], S[2 * pp][1]); w.y = pg8::cvt_pk_bf16(S[2 * pp][2], S[2 * pp][3]);
            w.z = pg8::cvt_pk_bf16(S[2 * pp + 1][0], S[2 * pp + 1][1]); w.w = pg8::cvt_pk_bf16(S[2 * pp + 1][2], S[2 * pp + 1][3]);
            Pf[pp] = __builtin_bit_cast(bf16x8, w);
        }
        f32x4 O[4];
#pragma unroll
        for (int dt = 0; dt < 4; ++dt) O[dt] = (f32x4){0.f, 0.f, 0.f, 0.f};
        const LAS unsigned char* vb = kb + vbase;
        u32x2 w8; w8.x = pg8::cvt_pk_bf16(S[8][0], S[8][1]); w8.y = pg8::cvt_pk_bf16(S[8][2], S[8][3]);
        const s16x4 P8 = __builtin_bit_cast(s16x4, w8);
#pragma unroll
        for (int pp = 0; pp < 4; ++pp)
#pragma unroll
            for (int dt = 0; dt < 4; ++dt) {
                const LAS unsigned char* a1 = vb + (32 * pp) * 128 + 32 * (dt ^ fvh);
                const s16x4 lo = __builtin_amdgcn_ds_read_tr16_b64_v4i16((LAS s16x4*)a1);
                const s16x4 hi = __builtin_amdgcn_ds_read_tr16_b64_v4i16((LAS s16x4*)(a1 + 16 * 128));
                bf16x8 Vf; Vf[0] = lo[0]; Vf[1] = lo[1]; Vf[2] = lo[2]; Vf[3] = lo[3]; Vf[4] = hi[0]; Vf[5] = hi[1]; Vf[6] = hi[2]; Vf[7] = hi[3];
                O[dt] = __builtin_amdgcn_mfma_f32_16x16x32_bf16(Vf, Pf[pp], O[dt], 0, 0, 0);
            }
#pragma unroll
        for (int dt = 0; dt < 4; ++dt) {
            const s16x4 v8 = __builtin_amdgcn_ds_read_tr16_b64_v4i16((LAS s16x4*)(vb + 128 * 128 + 32 * (dt ^ fvh)));
            O[dt] = __builtin_amdgcn_mfma_f32_16x16x16bf16_1k(v8, P8, O[dt], 0, 0, 0);
        }
        const float inv = fast_rcp(sum);
        bf16_t* orow = Ob + (rb + 64 * usel + qi) * 64;
#pragma unroll
        for (int dt = 0; dt < 4; ++dt) {
            u32x2 w; w.x = pg8::cvt_pk_bf16(O[dt][0] * inv, O[dt][1] * inv); w.y = pg8::cvt_pk_bf16(O[dt][2] * inv, O[dt][3] * inv);
            *(u32x2*)(orow + 16 * dt + 4 * fq) = w;
        }
        if (fq == 0) lse[(size_t)(b * SEQ + ((64 * n + qi) << dsh) + r) * NHEADS + hh] = mx + __builtin_amdgcn_logf(sum);
        buf ^= 1;
    }
    __syncthreads();
#undef ATT_DECODE
#undef ATT_ISSUE
}

__device__ __forceinline__ void elem_phase(const Ptrs& F, bf16_t* P, const bf16_t* Ob, const bf16_t* ZA, const float* lse, int vcu, int G) {
    int tid_ = threadIdx.x; asm volatile("" : "+v"(tid_));
    const int tid = tid_, lane = tid & 63, wave = tid >> 6;
    f32x4 cw[2][4][2];
#pragma unroll
    for (int ii = 0; ii < 2; ++ii) { const int ch = 8 * (lane + 64 * ii);
#pragma unroll
        for (int t = 0; t < 3; ++t) { cw[ii][t][0] = *(const f32x4*)(F.conv_w + t * DM + ch); cw[ii][t][1] = *(const f32x4*)(F.conv_w + t * DM + ch + 4); }
        cw[ii][3][0] = *(const f32x4*)(F.conv_b + ch); cw[ii][3][1] = *(const f32x4*)(F.conv_b + ch + 4); }
    for (int rb = vcu; rb < MP / 16; rb += G) {
        const int row = rb * 16 + 2 * wave, s = row & (SEQ - 1);
        bf16_t* pr = P + (size_t)row * NP; const int bb = row >> 12;
#pragma unroll
        for (int ii = 0; ii < 2; ++ii) {
            const int ch = 8 * (lane + 64 * ii);
            float bz0[8], bz1[8], um[8], u0[8], u1[8], u2[8];
            const u32x4 z4 = (u32x4){0u, 0u, 0u, 0u};
            unpack8(__builtin_nontemporal_load((const u32x4*)(pr + OFF_BZ + ch)), bz0); unpack8(__builtin_nontemporal_load((const u32x4*)(pr + NP + OFF_BZ + ch)), bz1);
            unpack8(*(const u32x4*)(pr + OFF_U + ch), u0); unpack8(*(const u32x4*)(pr + NP + OFF_U + ch), u1);
            unpack8(s > 0 ? *(const u32x4*)(pr - NP + OFF_U + ch) : z4, um); unpack8(s + 1 < SEQ - 1 ? *(const u32x4*)(pr + 2 * NP + OFF_U + ch) : z4, u2);
            f32x4 y0[2], y1[2];
#pragma unroll
            for (int j = 0; j < 8; ++j) {
                const float w0 = cw[ii][0][j >> 2][j & 3], w1 = cw[ii][1][j >> 2][j & 3], w2 = cw[ii][2][j >> 2][j & 3], cb = cw[ii][3][j >> 2][j & 3];
                y0[j >> 2][j & 3] = bz0[j] * (um[j] * w0 + u0[j] * w1 + u1[j] * w2 + cb);
                y1[j >> 2][j & 3] = bz1[j] * (u0[j] * w0 + u1[j] * w1 + u2[j] * w2 + cb);
            }
            *(u32x4*)(pr + OFF_YC + ch) = pack8(y0[0], y0[1]);
            *(u32x4*)(pr + NP + OFF_YC + ch) = pack8(y1[0], y1[1]);
        }
        {
            const int h = lane >> 3, dc = (lane & 7) * 8;
#pragma unroll
            for (int rr = 0; rr < 2; ++rr) {
                const int sr = s + rr;
                const float* lp = lse + (size_t)(row + rr) * NHEADS + h;
                const float L0 = lp[0], L1 = lp[8], L2 = lp[16];
                const float mx = fmaxf(L0, fmaxf(L1, L2));
                float w0 = fast_exp2(L0 - mx), w1 = fast_exp2(L1 - mx), w2 = fast_exp2(L2 - mx);
                const float inv = fast_rcp(w0 + w1 + w2); w0 *= inv; w1 *= inv; w2 *= inv;
                float o0[8], o1[8], o2[8], za[8];
                const bf16_t* ob = Ob + ((size_t)(bb * NHEADS + h) * SEQ) * 64 + dc;
                unpack8(__builtin_nontemporal_load((const u32x4*)(ob + (size_t)sr * 64)), o0);
                unpack8(__builtin_nontemporal_load((const u32x4*)(ob + ((size_t)8 * SEQ + ((sr & 3) << 10) + (sr >> 2)) * 64)), o1);
                unpack8(__builtin_nontemporal_load((const u32x4*)(ob + ((size_t)16 * SEQ + ((sr & 15) << 8) + (sr >> 4)) * 64)), o2);
                unpack8(*(const u32x4*)(pr + rr * NP + OFF_ZA + h * 64 + dc), za);
                f32x4 y[2];
#pragma unroll
                for (int j = 0; j < 8; ++j) y[j >> 2][j & 3] = (w0 * o0[j] + w1 * o1[j] + w2 * o2[j]) * siluf_(za[j]);
                *(u32x4*)(pr + rr * NP + OFF_YA + h * 64 + dc) = pack8(y[0], y[1]);
            }
        }
    }
}

#define XB_TMO      128
#define XB_XCNT(j)  (256  + 64 * (j))
#define XB_XSUB(j)  (1280 + 64 * (j))
#define XB_XGEN(j)  (2304 + 64 * (j))
#define XB_TOP      3328
#define XB_TOPGEN   3392
#define XCD_BAR_WORDS 3456
#define XB_SPIN_CAP (1u << 18)

__device__ __forceinline__ unsigned xb_ld(unsigned* p)              { return __hip_atomic_load(p, __ATOMIC_RELAXED, __HIP_MEMORY_SCOPE_AGENT); }
__device__ __forceinline__ unsigned xb_add(unsigned* p, unsigned v) { return __hip_atomic_fetch_add(p, v, __ATOMIC_RELAXED, __HIP_MEMORY_SCOPE_AGENT); }
__device__ __forceinline__ unsigned xb_xcc_id() { return (unsigned)__builtin_amdgcn_s_getreg((3 << 11) | 20) & 0xFu; }
#define XB_SPIN(cond, bar) do { unsigned _sp = 0; while (cond) { __builtin_amdgcn_s_sleep(1); \
    if ((++_sp & 255u) == 0u) { if (xb_ld(&(bar)[XB_TMO])) break; if (_sp > XB_SPIN_CAP) { atomicAdd(&(bar)[XB_TMO], 1u); break; } } } } while (0)

struct XcdBarrier {
    unsigned* bar; unsigned x;
    volatile LAS unsigned* st;
};

__device__ __forceinline__ XcdBarrier xcd_barrier_post(unsigned* bar, volatile LAS unsigned* st) {
    XcdBarrier b; b.bar = bar; b.x = xb_xcc_id(); b.st = st;
    if (threadIdx.x == 0) (void)xb_add(&bar[XB_XCNT(b.x)], 1u);
    return b;
}
__device__ __forceinline__ void xcd_barrier_complete(unsigned* bar, unsigned x, unsigned& nloc, unsigned& nx) {
    const unsigned G = gridDim.x * gridDim.y * gridDim.z;
    unsigned sum, cnt, mine, sp = 0u;
    for (;;) {
        sum = 0u; cnt = 0u; mine = 0u;
#pragma unroll
        for (unsigned j = 0; j < 16; ++j) { const unsigned c = xb_ld(&bar[XB_XCNT(j)]); sum += c; cnt += (c > 0u) ? 1u : 0u; mine = (j == x) ? c : mine; }
        if (sum == G) break;
        __builtin_amdgcn_s_sleep(1);
        if ((++sp & 255u) == 0u) { if (xb_ld(&bar[XB_TMO])) break; if (sp > XB_SPIN_CAP) { atomicAdd(&bar[XB_TMO], 1u); break; } }
    }
    nloc = mine > 0u ? mine : 1u; nx = cnt > 0u ? cnt : 1u;
}

__device__ __forceinline__ void xcd_barrier(const XcdBarrier& b) {
    asm volatile("s_waitcnt vmcnt(0)" ::: "memory");
    __syncthreads();
    if (threadIdx.x == 0) {
        unsigned* bar = b.bar;
        __builtin_amdgcn_s_waitcnt(0);
        unsigned nloc = b.st[0], nx = b.st[1];
        if (nloc == 0u) { xcd_barrier_complete(bar, b.x, nloc, nx); b.st[0] = nloc; b.st[1] = nx; }
        const unsigned old = xb_add(&bar[XB_XSUB(b.x)], 1u);
        const unsigned gen = old / nloc;
        if (old + 1u == (gen + 1u) * nloc) {
            __builtin_amdgcn_fence(__ATOMIC_RELEASE, "agent");
            asm volatile("s_waitcnt vmcnt(0)" ::: "memory");
            const unsigned og = xb_add(&bar[XB_TOP], 1u);
            const unsigned tg = og / nx;
            if (og + 1u == (tg + 1u) * nx) xb_add(&bar[XB_TOPGEN], 1u);
            else XB_SPIN(xb_ld(&bar[XB_TOPGEN]) == tg, bar);
            __builtin_amdgcn_fence(__ATOMIC_ACQUIRE, "agent");
            xb_add(&bar[XB_XGEN(b.x)], 1u);
            asm volatile("s_waitcnt vmcnt(0)" ::: "memory");
        } else {
            XB_SPIN(xb_ld(&bar[XB_XGEN(b.x)]) == gen, bar);
            __builtin_amdgcn_fence(__ATOMIC_ACQUIRE, "agent");
            asm volatile("s_waitcnt vmcnt(0)" ::: "memory");
        }
    }
    __syncthreads();
}


struct Args { const float* in[10]; float* out; unsigned char* ws; int pad0, pad1; };

__global__ void __launch_bounds__(NTHREADS, 2) fwd_kernel(Args args) {
    extern __shared__ __attribute__((aligned(16))) unsigned char lds_raw[];
    LAS unsigned char* lds = (LAS unsigned char*)lds_raw;
    cg::grid_group grid = cg::this_grid();
    const int G = gridDim.x, bx = blockIdx.x;
    const int vcu = (G % 8 == 0) ? (bx % 8) * (G / 8) + bx / 8 : bx;
    unsigned char* ws = args.ws;
    Ptrs F;
    F.x = args.in[0]; F.norm_g = args.in[1]; F.w_in = args.in[2]; F.conv_w = args.in[3]; F.conv_b = args.in[4]; F.qg = args.in[5]; F.kg = args.in[6];
    F.wbc = args.in[7]; F.wba = args.in[8]; F.wout = args.in[9]; F.out = args.out;
    F.WinT = (bf16_t*)(ws + WS_WIN); F.WcatT = (bf16_t*)(ws + WS_WCAT); F.WoutT = (bf16_t*)(ws + WS_WOUT);
    F.XN = (bf16_t*)args.out;
    F.PROJ = (bf16_t*)(ws + WS_PROJ); F.Mb = F.PROJ + OFF_U; F.Qb = (bf16_t*)(ws + WS_Q); F.Kb = (bf16_t*)(ws + WS_K); F.Vb = (bf16_t*)(ws + WS_V); F.ZA = (bf16_t*)(ws + WS_ZA);
    F.rope = (float*)(ws + WS_ROPE); F.lse = (float*)(ws + WS_LSE);
    unsigned* barw = (unsigned*)(ws + WS_BAR);
    volatile LAS unsigned* st = (volatile LAS unsigned*)(lds + 131072);
    if (threadIdx.x < 64) st[threadIdx.x] = 0u;
    __syncthreads();
    XcdBarrier xbar = xcd_barrier_post(barw, st);
    if (args.pad0 != 0) grid.sync();

    prologue(F, lds, vcu, G);
    xcd_barrier(xbar);

    bf16_t* GC = (bf16_t*)(ws + WS_GC); bf16_t* GA = (bf16_t*)(ws + WS_GA);
    EpiProj EP{F.PROJ, F.Qb, F.ZA, GC, F.qg, F.kg, F.rope};
    if (((bx >> 3) & 1) != 0) late_transposes(F, lds, ((((bx >> 4) << 3) | (bx & 7)) * NWAVES) + (threadIdx.x >> 6), (G >> 1) * NWAVES);
    {
        pg8::Gemm g{F.XN, F.WinT, DM, DM, DM}; pg8::StaticOrder S; S.init(MP, 36 * 256, G, bx, 0);
        pg8::gemm_phase<EpiProj, pg8::StaticOrder>(lds, g, S, EP);
    }
    xcd_barrier(xbar);
    attn_phase(lds, F.Qb, F.Kb, F.Vb, F.Qb, F.lse, vcu, G);
    xcd_barrier(xbar);
    const bool elem_first = (bx & 1) != 0;
    if (elem_first) elem_phase(F, F.PROJ, F.Qb, F.ZA, F.lse, vcu, G);
    {
        pg8::Gemm g{F.XN, F.WinT, DM, DM, DM};
        pg8::StaticOrder S2; S2.init(MP, 8 * 256, G, bx, 36);
        pg8::gemm_phase<EpiProj, pg8::StaticOrder>(lds, g, S2, EP);
    }
    if (!elem_first) elem_phase(F, F.PROJ, F.Qb, F.ZA, F.lse, vcu, G);
    xcd_barrier(xbar);
    {
        pg8::Gemm g{F.PROJ, F.WcatT, NP, 1536, 1536}; pg8::StaticOrder S; S.init(MP, DM, G, bx);
        EpiMerge E{GC, GA, F.Mb};
        pg8::gemm_phase<EpiMerge, pg8::StaticOrder>(lds, g, S, E);
    }
    xcd_barrier(xbar);
    {
        pg8::Gemm g{F.Mb, F.WoutT, NP, DM, DM}; pg8::StaticOrder S; S.init(MP, DM, G, bx);
        EpiOut E{F.x, F.out};
        pg8::gemm_phase<EpiOut, pg8::StaticOrder>(lds, g, S, E);
    }
}

extern "C" void kernel_launch(void* const* d_in, const int* in_sizes, int n_in, void* d_out, int out_size, void* d_ws, size_t ws_size, hipStream_t stream) {
    static int grid = 0;
    if (grid == 0) {
        if (n_in != 10 || in_sizes[0] != MTOT * DM || out_size != MTOT * DM || ws_size < WS_END) {
            fprintf(stderr, "kernel_launch: unexpected shapes (n_in %d, in0 %d, out %d, ws %zu)\n", n_in, n_in > 0 ? in_sizes[0] : -1, out_size, ws_size); grid = -1; return; }
        int dev = 0, cus = 0, per_cu = 0;
        hipGetDevice(&dev);
        hipDeviceGetAttribute(&cus, hipDeviceAttributeMultiprocessorCount, dev);
        if (hipFuncSetAttribute((const void*)fwd_kernel, hipFuncAttributeMaxDynamicSharedMemorySize, LDS_BYTES) != hipSuccess) { fprintf(stderr, "kernel_launch: hipFuncSetAttribute failed\n"); grid = -1; return; }
        if (hipOccupancyMaxActiveBlocksPerMultiprocessor(&per_cu, (const void*)fwd_kernel, NTHREADS, LDS_BYTES) != hipSuccess || per_cu < 1) { fprintf(stderr, "kernel_launch: occupancy query failed (%d)\n", per_cu); per_cu = 1; }
        (void)hipGetLastError();
        grid = cus * per_cu;
    }
    if (grid < 0) return;
    if (hipMemsetAsync((char*)d_ws + WS_BAR, 0, XCD_BAR_WORDS * 4, stream) != hipSuccess) { fprintf(stderr, "kernel_launch: memset failed\n"); return; }
    Args a{};
    for (int i = 0; i < 10; ++i) a.in[i] = (const float*)d_in[i];
    a.out = (float*)d_out; a.ws = (unsigned char*)d_ws;
    void* kargs[] = {&a};
    hipError_t e = hipLaunchCooperativeKernel((const void*)fwd_kernel, dim3(grid), dim3(NTHREADS), kargs, LDS_BYTES, stream);
    if (e != hipSuccess) fprintf(stderr, "cooperative launch failed: %s (grid %d)\n", hipGetErrorString(e), grid);
}
```
